# Optimizing an MI355X kernel written in HIP

```python
import math
import jax, jax.numpy as jnp
from jax import lax
import numpy as np

D_MODEL = 1024
BATCH = 4
SEQ = 8192
DEPTH = 4

HEAD_DIM = 64
HG_W = D_MODEL // 4
HG_HEADS = HG_W // HEAD_DIM
NSA_W = D_MODEL // 2
NSA_HEADS = NSA_W // HEAD_DIM
NSA_GQA = 4
NSA_KV_HEADS = NSA_HEADS // NSA_GQA
KV_W = NSA_KV_HEADS * HEAD_DIM
GM_W = D_MODEL - HG_W - NSA_W
GM_HEADS = GM_W // HEAD_DIM
D_MIX = HG_W + NSA_W + GM_W
IN_COLS = 4 * HG_W + NSA_W + 6 * KV_W + 3 * NSA_HEADS + 2 * GM_W
D_FF = 4 * D_MODEL
ROPE_THETA = 10000.0
HGRN_CHUNK = 64
CMP_LEN = 32
CMP_STRIDE = 16
CMP_HIDDEN = 256
SLC_BLOCK = 64
SLC_TOPN = 16
WINDOW = 512
Q_BLOCK = 128
GMLP_CHUNK = 128
DN_ALPHA = (2 * DEPTH) ** 0.25
DN_BETA = (8 * DEPTH) ** -0.25
NEG = -1e30
BIG = 1e30
F_MIN = 1e-30

kernel_name = 'hymba_style_hgrn2_nsa_gmlp_deepnorm_adaln'


def layer_norm(x, w, b, eps=1e-5):
    xf = x.astype(jnp.float32)
    mu = jnp.mean(xf, axis=-1, keepdims=True)
    var = jnp.mean(jnp.square(xf - mu), axis=-1, keepdims=True)
    y = (xf - mu) * lax.rsqrt(var + eps)
    return (y * w.astype(jnp.float32) + b.astype(jnp.float32)).astype(x.dtype)


def rope(a, cos, sin):
    half = a.shape[-1] // 2
    a1, a2 = a[..., :half], a[..., half:]
    return jnp.concatenate([a1 * cos - a2 * sin, a2 * cos + a1 * sin], axis=-1).astype(a.dtype)


def hgrn2(q, f_raw, i, g, lb, norm_w):
    B_, S_, H, dk = q.shape
    dt = q.dtype
    C = HGRN_CHUNK
    lb = lb.astype(jnp.float32).reshape(H, dk)
    z = f_raw.astype(jnp.float32)
    f = lb + (1.0 - lb) * jax.nn.sigmoid(z)
    log_f = jnp.log(jnp.maximum(f, F_MIN))
    k = (1.0 - lb) * jax.nn.sigmoid(-z)
    qf = jax.nn.silu(q.astype(jnp.float32))
    v = i.astype(jnp.float32)
    nC = S_ // C

    def chunks(a):
        return a.reshape(B_, nC, C, H, dk).transpose(1, 0, 3, 2, 4)

    qc, kc, vc = chunks(qf), chunks(k), chunks(v)
    bc = jnp.cumsum(chunks(log_f), axis=3)
    causal = jnp.tril(jnp.ones((C, C), bool))

    def step(state, inp):
        q_, k_, v_, b_ = inp
        rel = b_[:, :, :, None, :] - b_[:, :, None, :, :]
        decay = jnp.exp(jnp.where(causal[:, :, None], rel, NEG))
        attn = jnp.einsum('bhtk,bhtsk,bhsk->bhts', q_, decay, k_)
        o = attn @ v_ + jnp.einsum('bhtk,bhkv->bhtv', q_ * jnp.exp(b_), state)
        b_last = b_[:, :, -1:, :]
        state = (jnp.exp(b_last[:, :, 0, :])[..., None] * state
                 + jnp.einsum('bhsk,bhsv->bhkv', k_ * jnp.exp(b_last - b_), v_))
        return state, o

    s0 = jnp.zeros((B_, H, dk, dk), jnp.float32)
    _, o = lax.scan(step, s0, (qc, kc, vc, bc))
    o = o.transpose(1, 0, 3, 2, 4).reshape(B_, S_, H, dk)
    o = o * lax.rsqrt(jnp.mean(jnp.square(o), axis=-1, keepdims=True) + 1e-6) * norm_w.astype(jnp.float32)
    o = o * jax.nn.silu(g.astype(jnp.float32))
    return o.reshape(B_, S_, H * dk).astype(dt)


def compress(a, pe, w1, w2):
    B_, S_, Hk, dh = a.shape
    seg = a.reshape(B_, S_ // CMP_STRIDE, CMP_STRIDE, Hk, dh)
    blk = jnp.concatenate([seg[:, :-1], seg[:, 1:]], axis=2)
    blk = blk + pe[None, None, :, None, :]
    nC = blk.shape[1]
    blk = blk.transpose(0, 1, 3, 2, 4).reshape(B_, nC, Hk, CMP_LEN * dh)
    return jax.nn.gelu(blk @ w1) @ w2


def nsa(q, k_cmp, v_cmp, k_slc, v_slc, k_win, v_win, gates, pe_k, w1k, w2k, pe_v, w1v, w2v):
    B_, S_, H, dh = q.shape
    Hk, G = NSA_KV_HEADS, NSA_GQA
    dt = q.dtype
    qg = (q * (dh ** -0.5)).reshape(B_, S_, Hk, G, dh)
    kc = compress(k_cmp, pe_k, w1k, w2k)
    vc = compress(v_cmp, pe_v, w1v, w2v)
    nC = kc.shape[1]
    nS = S_ // SLC_BLOCK
    topn = min(SLC_TOPN, nS)
    cmp_end = jnp.arange(nC) * CMP_STRIDE + CMP_LEN - 1
    cs = np.arange(nC) * CMP_STRIDE
    ss = np.arange(nS) * SLC_BLOCK
    overlap = jnp.asarray(((cs[:, None] < ss[None, :] + SLC_BLOCK) & (ss[None, :] < cs[:, None] + CMP_LEN)).astype(np.float32))
    ks_b = k_slc.reshape(B_, nS, SLC_BLOCK, Hk, dh).transpose(0, 3, 1, 2, 4)
    vs_b = v_slc.reshape(B_, nS, SLC_BLOCK, Hk, dh).transpose(0, 3, 1, 2, 4)
    kw_pad = jnp.pad(k_win, ((0, 0), (WINDOW, 0), (0, 0), (0, 0)))
    vw_pad = jnp.pad(v_win, ((0, 0), (WINDOW, 0), (0, 0), (0, 0)))
    bidx = jnp.arange(B_)[:, None, None, None]
    hidx = jnp.arange(Hk)[None, :, None, None]
    j = jnp.arange(nS)
    in_blk = jnp.arange(SLC_BLOCK)
    win_off = jnp.arange(WINDOW + Q_BLOCK) - WINDOW

    def block(qb):
        q0 = qb * Q_BLOCK
        t = q0 + jnp.arange(Q_BLOCK)
        q_blk = lax.dynamic_slice_in_dim(qg, q0, Q_BLOCK, axis=1)
        g_blk = lax.dynamic_slice_in_dim(gates, q0, Q_BLOCK, axis=1)
        s = jnp.einsum('bqhgd,bnhd->bhgqn', q_blk, kc).astype(jnp.float32)
        m = cmp_end[None, :] <= t[:, None]
        p_cmp = jax.nn.softmax(jnp.where(m, s, NEG), axis=-1) * m
        o_cmp = jnp.einsum('bhgqn,bnhd->bqhgd', p_cmp.astype(dt), vc)
        imp = jnp.einsum('bhgqn,nj->bhqj', p_cmp, overlap)
        tb = t // SLC_BLOCK
        forced = (j[None] == 0) | (j[None] == tb[:, None]) | (j[None] == tb[:, None] - 1)
        score = jnp.where(j[None] > tb[:, None], NEG, jnp.where(forced, BIG, imp))
        _, idx = lax.top_k(score, topn)
        k_sel = ks_b[bidx, hidx, idx].reshape(B_, Hk, Q_BLOCK, topn * SLC_BLOCK, dh)
        v_sel = vs_b[bidx, hidx, idx].reshape(B_, Hk, Q_BLOCK, topn * SLC_BLOCK, dh)
        kpos = (idx[..., None] * SLC_BLOCK + in_blk).reshape(B_, Hk, Q_BLOCK, topn * SLC_BLOCK)
        s = jnp.einsum('bqhgd,bhqkd->bhgqk', q_blk, k_sel).astype(jnp.float32)
        m = (kpos <= t[None, None, :, None])[:, :, None]
        p = jax.nn.softmax(jnp.where(m, s, NEG), axis=-1)
        o_slc = jnp.einsum('bhgqk,bhqkd->bqhgd', p.astype(dt), v_sel)
        k_w = lax.dynamic_slice_in_dim(kw_pad, q0, WINDOW + Q_BLOCK, axis=1)
        v_w = lax.dynamic_slice_in_dim(vw_pad, q0, WINDOW + Q_BLOCK, axis=1)
        kp = q0 + win_off
        m = (kp[None] <= t[:, None]) & (kp[None] > t[:, None] - WINDOW) & (kp[None] >= 0)
        s = jnp.einsum('bqhgd,bkhd->bhgqk', q_blk, k_w).astype(jnp.float32)
        p = jax.nn.softmax(jnp.where(m, s, NEG), axis=-1)
        o_win = jnp.einsum('bhgqk,bkhd->bqhgd', p.astype(dt), v_w)
        out = g_blk[..., 0:1] * o_cmp + g_blk[..., 1:2] * o_slc + g_blk[..., 2:3] * o_win
        return out.astype(dt)

    out = lax.map(block, jnp.arange(S_ // Q_BLOCK))
    return out.transpose(1, 0, 2, 3, 4, 5).reshape(B_, S_, H * dh)


def gmlp(u_raw, v_raw, nw, nb, w_s, b_s):
    B_, S_, W = u_raw.shape
    u = jax.nn.gelu(u_raw)
    v = layer_norm(jax.nn.gelu(v_raw), nw, nb)
    v = v.reshape(B_, S_ // GMLP_CHUNK, GMLP_CHUNK, GM_HEADS, W // GM_HEADS)
    w = w_s * jnp.tril(jnp.ones((GMLP_CHUNK, GMLP_CHUNK), w_s.dtype))
    sv = jnp.einsum('gts,bnsgc->bntgc', w, v) + b_s.T[None, None, :, :, None]
    return u * sv.reshape(B_, S_, W)


def setup_inputs(seed: int = 0) -> dict:
    key = jax.random.key(seed)
    ks = jax.random.split(key, 32)
    L, D = DEPTH, D_MODEL

    def nrm(k, shape, scale):
        return jax.random.normal(k, shape, jnp.float32) * scale

    offs = jax.random.randint(ks[2], (BATCH, 1), 0, 4096, dtype=jnp.int32)
    return {
        'x': nrm(ks[0], (BATCH, SEQ, D), 1.0),
        'c': nrm(ks[1], (BATCH, D), 1.0),
        'positions': offs + jnp.arange(SEQ, dtype=jnp.int32)[None, :],
        'w_in': nrm(ks[3], (L, D, IN_COLS), D ** -0.5),
        'w_o': nrm(ks[4], (L, D_MIX, D), D_MIX ** -0.5 * DN_BETA),
        'hgrn_lower_bounds': 1.0 + nrm(ks[5], (L, HG_W), 0.1),
        'hgrn_norm_w': 1.0 + nrm(ks[6], (L, HEAD_DIM), 0.02),
        'cmp_pe_k': nrm(ks[7], (L, CMP_LEN, HEAD_DIM), 0.02),
        'cmp_w1_k': nrm(ks[8], (L, CMP_LEN * HEAD_DIM, CMP_HIDDEN), (CMP_LEN * HEAD_DIM) ** -0.5),
        'cmp_w2_k': nrm(ks[9], (L, CMP_HIDDEN, HEAD_DIM), CMP_HIDDEN ** -0.5),
        'cmp_pe_v': nrm(ks[10], (L, CMP_LEN, HEAD_DIM), 0.02),
        'cmp_w1_v': nrm(ks[11], (L, CMP_LEN * HEAD_DIM, CMP_HIDDEN), (CMP_LEN * HEAD_DIM) ** -0.5),
        'cmp_w2_v': nrm(ks[12], (L, CMP_HIDDEN, HEAD_DIM), CMP_HIDDEN ** -0.5),
        'gmlp_norm_w': 1.0 + nrm(ks[13], (L, GM_W), 0.02),
        'gmlp_norm_b': nrm(ks[14], (L, GM_W), 0.02),
        'gmlp_w_s': nrm(ks[15], (L, GM_HEADS, GMLP_CHUNK, GMLP_CHUNK), GMLP_CHUNK ** -0.5),
        'gmlp_b_s': 1.0 + nrm(ks[16], (L, GM_HEADS, GMLP_CHUNK), 0.02),
        'w_ff1': nrm(ks[17], (L, D, D_FF), D ** -0.5),
        'w_ff2': nrm(ks[18], (L, D_FF, D), D_FF ** -0.5 * DN_BETA),
        'w_ada': nrm(ks[19], (L, D, 6 * D), 0.1 * D ** -0.5),
        'b_ada': nrm(ks[20], (L, 6 * D), 0.02),
        'ln1_w': 1.0 + nrm(ks[21], (L, D), 0.02),
        'ln1_b': nrm(ks[22], (L, D), 0.02),
        'ln2_w': 1.0 + nrm(ks[23], (L, D), 0.02),
        'ln2_b': nrm(ks[24], (L, D), 0.02),
    }


def reference(x, c, positions, w_in, w_o, hgrn_lower_bounds, hgrn_norm_w,
              cmp_pe_k, cmp_w1_k, cmp_w2_k, cmp_pe_v, cmp_w1_v, cmp_w2_v,
              gmlp_norm_w, gmlp_norm_b, gmlp_w_s, gmlp_b_s,
              w_ff1, w_ff2, w_ada, b_ada, ln1_w, ln1_b, ln2_w, ln2_b):
    B_, S_, D = x.shape
    inv_freq = ROPE_THETA ** (-jnp.arange(0, HEAD_DIM, 2, dtype=jnp.float32) / HEAD_DIM)
    ang = positions.astype(jnp.float32)[..., None] * inv_freq
    cos, sin = jnp.cos(ang)[:, :, None, :], jnp.sin(ang)[:, :, None, :]
    lb_sm = jax.nn.softmax(hgrn_lower_bounds.astype(jnp.float32), axis=0)
    lb_all = jnp.cumsum(lb_sm, axis=0) - lb_sm[0:1]
    sizes = [HG_W] * 4 + [NSA_W] + [KV_W] * 6 + [3 * NSA_HEADS] + [GM_W] * 2
    cuts = [int(v) for v in np.cumsum(sizes)[:-1]]
    ada_in = jax.nn.silu(c)
    for l in range(DEPTH):
        mod = (ada_in @ w_ada[l] + b_ada[l])[:, None, :]
        sh1, sc1, g1, sh2, sc2, g2 = jnp.split(mod, 6, axis=-1)
        h = x * (1.0 + sc1) + sh1
        proj = h @ w_in[l]
        (hq, hf, hi, hg, nq, kcm, vcm, ksl, vsl, kwn, vwn, ngt, gu, gv) = jnp.split(proj, cuts, axis=-1)
        hs = lambda a, n: a.reshape(B_, S_, n, HEAD_DIM)
        o_h = hgrn2(hs(hq, HG_HEADS), hs(hf, HG_HEADS), hs(hi, HG_HEADS), hs(hg, HG_HEADS),
                    lb_all[l], hgrn_norm_w[l])
        q_n = rope(hs(nq, NSA_HEADS), cos, sin)
        gates = jax.nn.sigmoid(ngt.astype(jnp.float32)).reshape(B_, S_, NSA_KV_HEADS, NSA_GQA, 3)
        o_n = nsa(q_n,
                  rope(hs(kcm, NSA_KV_HEADS), cos, sin), hs(vcm, NSA_KV_HEADS),
                  rope(hs(ksl, NSA_KV_HEADS), cos, sin), hs(vsl, NSA_KV_HEADS),
                  rope(hs(kwn, NSA_KV_HEADS), cos, sin), hs(vwn, NSA_KV_HEADS),
                  gates, cmp_pe_k[l], cmp_w1_k[l], cmp_w2_k[l], cmp_pe_v[l], cmp_w1_v[l], cmp_w2_v[l])
        o_g = gmlp(gu, gv, gmlp_norm_w[l], gmlp_norm_b[l], gmlp_w_s[l], gmlp_b_s[l])
        mix = jnp.concatenate([o_h, o_n, o_g], axis=-1) @ w_o[l]
        x = layer_norm(DN_ALPHA * x + (1.0 + g1) * mix, ln1_w[l], ln1_b[l])
        h = x * (1.0 + sc2) + sh2
        y = jnp.square(jax.nn.relu(h @ w_ff1[l])) @ w_ff2[l]
        x = layer_norm(DN_ALPHA * x + (1.0 + g2) * y, ln2_w[l], ln2_b[l])
    return x
```

```cpp
#include <hip/hip_runtime.h>
#include <hip/hip_bf16.h>
#include <hip/hip_cooperative_groups.h>
#include <cstdio>
#include <cmath>
namespace cg = cooperative_groups;

#ifndef REPMASK
#define REPMASK 0
#endif
#ifndef MULTI_LAUNCH
#define MULTI_LAUNCH 0
#endif

typedef unsigned short u16;
using bf16x8 = __attribute__((ext_vector_type(8))) short;
using f32x16 = __attribute__((ext_vector_type(16))) float;
using f32x4 = __attribute__((ext_vector_type(4))) float;
#define DI __device__ __forceinline__

constexpr int NT = 512;
constexpr int T_ = 32768, S_ = 8192, D_ = 1024, PW = 2944, DFF = 4096;
constexpr float NEGF = -1e30f;
constexpr float DN_ALPHA = 1.681792830507429f;

constexpr size_t OFF_WIN = 0;
constexpr int NPI = 3072;
constexpr size_t OFF_WO  = OFF_WIN + 4ull * NPI * 1024 * 2;
constexpr size_t OFF_FF1 = OFF_WO + 4ull * 1024 * 1024 * 2;
constexpr size_t OFF_FF2 = OFF_FF1 + 4ull * 4096 * 1024 * 2;
constexpr size_t OFF_CW1 = OFF_FF2 + 4ull * 4096 * 1024 * 2;
constexpr size_t OFF_CW2 = OFF_CW1 + 4ull * 2 * 256 * 2048 * 2;
constexpr size_t OFF_MOD = OFF_CW2 + 4ull * 2 * 128 * 256 * 2;
constexpr size_t OFF_COS = OFF_MOD + 4ull * 4 * 6144 * 4;
constexpr size_t OFF_SIN = OFF_COS + (size_t)T_ * 32 * 4;
constexpr size_t OFF_LB  = OFF_SIN + (size_t)T_ * 32 * 4;
constexpr size_t OFF_CB  = OFF_LB + 4096;
constexpr size_t OFF_BAR = OFF_CB + 8192;
constexpr size_t OFF_WSB = OFF_BAR + 16384;
constexpr size_t OFF_H   = OFF_WSB + 524288;
constexpr size_t OFF_BIG = OFF_H + (size_t)T_ * 1024 * 2;
constexpr size_t OFF_MIX = OFF_BIG + (size_t)T_ * PW * 2;
constexpr size_t OFF_BIGEND = OFF_BIG + (size_t)T_ * 4096 * 2;
constexpr size_t OFF_VTS = OFF_BIGEND;
constexpr size_t OFF_VTW = OFF_VTS + 8388608;
constexpr size_t OFF_ST  = OFF_VTW + 8388608;
constexpr size_t OFF_DEC = OFF_ST + 33554432;
constexpr size_t OFF_CH  = OFF_DEC + 524288;
constexpr size_t OFF_KC  = OFF_CH + 4194304;
constexpr size_t OFF_VCT = OFF_KC + 524288;
constexpr size_t OFF_YL  = OFF_VTS;
constexpr size_t WS_END  = OFF_YL + (size_t)T_ * 1024 * 2;

struct P {
  const float* in[25];
  float* out;
  char* ws;
  double invf[32];
  double cf[16];
  int ph_lo, ph_hi;
  int rep_mask, pad_;
};

DI u16 f2bf(float x) { unsigned u = __float_as_uint(x); u += 0x7fffu + ((u >> 16) & 1u); return (u16)(u >> 16); }
DI float bf2f(u16 h) { return __uint_as_float(((unsigned)h) << 16); }
typedef __bf16 bf2_t __attribute__((ext_vector_type(2)));
typedef float f2_t __attribute__((ext_vector_type(2)));
DI unsigned pack2(float a, float b) { f2_t v = {a, b}; bf2_t r = __builtin_convertvector(v, bf2_t); return __builtin_bit_cast(unsigned, r); }
typedef _Float16 h8_t __attribute__((ext_vector_type(8)));
typedef _Float16 h2_t __attribute__((ext_vector_type(2)));
typedef float f2h_t __attribute__((ext_vector_type(2)));
DI unsigned pack2h(float a, float b) { f2h_t v = {a, b}; h2_t r = __builtin_convertvector(v, h2_t); return __builtin_bit_cast(unsigned, r); }
DI float hlo2f(unsigned u) { return (float)__builtin_bit_cast(_Float16, (unsigned short)(u & 0xffffu)); }
DI float hhi2f(unsigned u) { return (float)__builtin_bit_cast(_Float16, (unsigned short)(u >> 16)); }
DI float lo2f(unsigned u) { return __uint_as_float(u << 16); }
DI float hi2f(unsigned u) { return __uint_as_float(u & 0xffff0000u); }
DI int tidx() { int t = threadIdx.x; asm volatile("" : "+v"(t)); return t; }
DI float sigm(float x) { return 1.f / (1.f + __expf(-x)); }
DI float silu(float x) { return x / (1.f + __expf(-x)); }
DI float gelu_t(float x) { float u = 0.7978845608028654f * (x + 0.044715f * x * x * x); return x / (1.f + __expf(-2.f * u)); }
DI f32x16 mfma32(bf16x8 a, bf16x8 b, f32x16 c) { return __builtin_amdgcn_mfma_f32_32x32x16_bf16(a, b, c, 0, 0, 0); }
DI f32x4 mfma16(bf16x8 a, bf16x8 b, f32x4 c) { return __builtin_amdgcn_mfma_f32_16x16x32_bf16(a, b, c, 0, 0, 0); }
DI float wsum(float v) { for (int o = 32; o > 0; o >>= 1) v += __shfl_xor(v, o); return v; }
DI void unpack8(uint4 r, float* f) {
  f[0] = lo2f(r.x); f[1] = hi2f(r.x); f[2] = lo2f(r.y); f[3] = hi2f(r.y);
  f[4] = lo2f(r.z); f[5] = hi2f(r.z); f[6] = lo2f(r.w); f[7] = hi2f(r.w);
}

constexpr int BM = 256, BN = 128, BK = 64, LDT = 72;
constexpr int SMEM_BYTES = 147456;

struct APlain { const u16* A; int lda; DI const u16* operator()(int row, int kt) const { return A + (size_t)row * lda + kt * 64; } };
struct ACmp { const u16* proj; int col0;
  DI const u16* operator()(int row, int kt) const {
    int n = row & 511, bh = row >> 9, b = bh >> 1, hk = bh & 1;
    int s = 16 * n + kt; s = s < S_ ? s : S_ - 1;
    return proj + (size_t)(b * S_ + s) * PW + col0 + hk * 64;
  } };

template <class AF, class EF>
DI void gemm_tile(AF af, const u16* __restrict__ Bt, int K, int m0, int n0, EF ef, char* smem) {
  u16* sA = (u16*)smem;
  u16* sB = sA + 2 * BM * LDT;
  const int tid = tidx(), lane = tid & 63, wid = tid >> 6, wm = wid >> 1, wn = wid & 1;
  const int cr = tid >> 3, cc = (tid & 7) * 8;
  f32x16 acc[2][2];
#pragma unroll
  for (int i = 0; i < 2; i++)
#pragma unroll
    for (int j = 0; j < 2; j++)
#pragma unroll
      for (int r = 0; r < 16; r++) acc[i][j][r] = 0.f;
  uint4 ra[4], rb[2];
  const int nk = K / BK;
#pragma unroll
  for (int i = 0; i < 4; i++) ra[i] = *(const uint4*)(af(m0 + cr + i * 64, 0) + cc);
#pragma unroll
  for (int i = 0; i < 2; i++) rb[i] = *(const uint4*)(Bt + (size_t)(n0 + cr + i * 64) * K + cc);
#pragma unroll
  for (int i = 0; i < 4; i++) *(uint4*)(sA + (cr + i * 64) * LDT + cc) = ra[i];
#pragma unroll
  for (int i = 0; i < 2; i++) *(uint4*)(sB + (cr + i * 64) * LDT + cc) = rb[i];
  __syncthreads();
  for (int kt = 0; kt < nk; kt++) {
    const int cur = kt & 1;
    if (kt + 1 < nk) {
#pragma unroll
      for (int i = 0; i < 4; i++) ra[i] = *(const uint4*)(af(m0 + cr + i * 64, kt + 1) + cc);
#pragma unroll
      for (int i = 0; i < 2; i++) rb[i] = *(const uint4*)(Bt + (size_t)(n0 + cr + i * 64) * K + (kt + 1) * 64 + cc);
    }
    const u16* a_ = sA + cur * BM * LDT + (wm * 64 + (lane & 31)) * LDT + (lane >> 5) * 8;
    const u16* b_ = sB + cur * BN * LDT + (wn * 64 + (lane & 31)) * LDT + (lane >> 5) * 8;
#pragma unroll
    for (int ks = 0; ks < 4; ks++) {
      bf16x8 fa0 = *(const bf16x8*)(a_ + ks * 16), fa1 = *(const bf16x8*)(a_ + 32 * LDT + ks * 16);
      bf16x8 fb0 = *(const bf16x8*)(b_ + ks * 16), fb1 = *(const bf16x8*)(b_ + 32 * LDT + ks * 16);
      acc[0][0] = mfma32(fb0, fa0, acc[0][0]);
      acc[0][1] = mfma32(fb1, fa0, acc[0][1]);
      acc[1][0] = mfma32(fb0, fa1, acc[1][0]);
      acc[1][1] = mfma32(fb1, fa1, acc[1][1]);
    }
    if (kt + 1 < nk) {
      u16* dA = sA + (cur ^ 1) * BM * LDT;
      u16* dB = sB + (cur ^ 1) * BN * LDT;
#pragma unroll
      for (int i = 0; i < 4; i++) *(uint4*)(dA + (cr + i * 64) * LDT + cc) = ra[i];
#pragma unroll
      for (int i = 0; i < 2; i++) *(uint4*)(dB + (cr + i * 64) * LDT + cc) = rb[i];
    }
    __syncthreads();
  }
  ef(m0 + wm * 64, n0 + wn * 64, acc, lane);
}

struct EpiPlain {
  u16* out; int ldo; int act; const float* bias;
  DI void operator()(int tm0, int tn0, f32x16 (&acc)[2][2], int lane) const {
    const int h = lane >> 5;
#pragma unroll
    for (int mi = 0; mi < 2; mi++) {
      const size_t row = (size_t)(tm0 + mi * 32 + (lane & 31));
#pragma unroll
      for (int ni = 0; ni < 2; ni++)
#pragma unroll
        for (int q = 0; q < 4; q++) {
          const int col = tn0 + ni * 32 + 8 * q + 4 * h;
          float v[4];
#pragma unroll
          for (int j = 0; j < 4; j++) {
            float x = acc[mi][ni][4 * q + j];
            if (act == 1) { x = fmaxf(x, 0.f); x = x * x; }
            else if (act == 2) { x = gelu_t(x + bias[col + j]); }
            v[j] = x;
          }
          uint2 pk; pk.x = pack2(v[0], v[1]); pk.y = pack2(v[2], v[3]);
          *(uint2*)(out + row * ldo + col) = pk;
        }
    }
  }
};

struct EpiInProj {
  u16* proj; u16* vts; u16* vtw; const float* cs; const float* sn;
  DI void operator()(int tm0, int tn0, f32x16 (&acc)[2][2], int lane) const {
    const int h = lane >> 5;
    const bool isrope = (tn0 >= 1024 && tn0 < 1664) || (tn0 >= 1792 && tn0 < 1920) || (tn0 >= 2048 && tn0 < 2176);
    const float scale = (tn0 >= 1024 && tn0 < 1536) ? 0.125f : 1.f;
    const bool isvts = (tn0 >= 1920 && tn0 < 2048), isvtw = (tn0 >= 2176 && tn0 < 2304);
#pragma unroll
    for (int mi = 0; mi < 2; mi++) {
      const int token = tm0 + mi * 32 + (lane & 31);
      if (isrope) {
#pragma unroll
        for (int q = 0; q < 4; q++) {
          const int d0 = 8 * q + 4 * h;
          const float4 c4 = *(const float4*)(cs + (size_t)token * 32 + d0);
          const float4 s4 = *(const float4*)(sn + (size_t)token * 32 + d0);
          const float cc[4] = {c4.x, c4.y, c4.z, c4.w}, ss[4] = {s4.x, s4.y, s4.z, s4.w};
#pragma unroll
          for (int j = 0; j < 4; j++) {
            const float a1 = acc[mi][0][4 * q + j], a2 = acc[mi][1][4 * q + j];
            acc[mi][0][4 * q + j] = (a1 * cc[j] - a2 * ss[j]) * scale;
            acc[mi][1][4 * q + j] = (a2 * cc[j] + a1 * ss[j]) * scale;
          }
        }
      }
      if (isvts || isvtw) {
        const int b = token / S_, s = token % S_;
        const int hk = ((tn0 - (isvts ? 1920 : 2176)) >> 6);
        u16* vt = (isvts ? vts : vtw) + (size_t)((b * 2 + hk) * 64) * S_ + s;
#pragma unroll
        for (int ni = 0; ni < 2; ni++)
#pragma unroll
          for (int r = 0; r < 16; r++) {
            const int dim = ni * 32 + 8 * (r >> 2) + 4 * h + (r & 3);
            vt[(size_t)dim * S_] = f2bf(acc[mi][ni][r]);
          }
      } else {
#pragma unroll
        for (int ni = 0; ni < 2; ni++)
#pragma unroll
          for (int q = 0; q < 4; q++) {
            const int col = tn0 + ni * 32 + 8 * q + 4 * h;
            uint2 pk; pk.x = pack2(acc[mi][ni][4 * q], acc[mi][ni][4 * q + 1]); pk.y = pack2(acc[mi][ni][4 * q + 2], acc[mi][ni][4 * q + 3]);
            *(uint2*)(proj + (size_t)token * PW + col) = pk;
          }
      }
    }
  }
};

struct EpiCmp2 {
  u16* kc; u16* vct; int kv;
  DI void operator()(int tm0, int tn0, f32x16 (&acc)[2][2], int lane) const {
    if (tn0 >= 64) return;
    const int h = lane >> 5;
#pragma unroll
    for (int mi = 0; mi < 2; mi++) {
      const int row = tm0 + mi * 32 + (lane & 31);
      const int n = row & 511, bh = row >> 9;
#pragma unroll
      for (int ni = 0; ni < 2; ni++)
#pragma unroll
        for (int r = 0; r < 16; r++) {
          const int dim = ni * 32 + 8 * (r >> 2) + 4 * h + (r & 3);
          const u16 v = f2bf(acc[mi][ni][r]);
          if (kv == 0) kc[(size_t)row * 64 + dim] = v;
          else vct[(size_t)(bh * 64 + dim) * 512 + n] = v;
        }
    }
  }
};


constexpr int G_BK = 64, G_HALF = 128, G_HT = G_HALF * G_BK;
constexpr int G_SHM = 8 * G_HT * 2;
DI int g_lds_byte(int r, int c) {
  int st = (r >> 4) * 2 + (c >> 5), rr = r & 15, cc = c & 31, ob = rr * 64 + cc * 2;
  return st * 1024 + (ob ^ (((ob >> 9) & 1) << 5));
}
DI void g_stage_rc(int b, int& R, int& C) {
  int st = b / 1024, sb = b % 1024, swz = sb ^ (((sb >> 9) & 1) << 5);
  R = (st >> 1) * 16 + swz / 64; C = (st & 1) * 32 + (swz % 64) / 2;
}
template <bool F16, class EF>
DI void gemm256_tile(const u16* __restrict__ A, const u16* __restrict__ Bt, int K, int brow, int bcol, EF ef, char* smem) {
  u16* shm = (u16*)smem;
  const int tid = tidx();
#define SA(b, h) (shm + ((b) * 2 + (h)) * G_HT)
#define SB(b, h) (shm + (4 + (b) * 2 + (h)) * G_HT)
#define STAGE(P_, BASE, br, kt) do { const u16* _gb = (BASE) + ((long)(br) * K + (long)(kt) * G_BK); \
    __builtin_amdgcn_global_load_lds((const unsigned*)(_gb + so0), (__attribute__((address_space(3))) unsigned*)((char*)(P_) + tid * 16), 16, 0, 0); \
    __builtin_amdgcn_global_load_lds((const unsigned*)(_gb + so1), (__attribute__((address_space(3))) unsigned*)((char*)(P_) + tid * 16 + 8192), 16, 0, 0); } while (0)
#define LDA(dst, b, h) for (int m = 0; m < 4; ++m) for (int k = 0; k < 2; ++k) \
    dst[m][k] = *reinterpret_cast<const bf16x8*>((char*)SA(b, h) + g_lds_byte(wr * 64 + m * 16 + fr, k * 32 + fq * 8))
#define LDB(dst, b, h) for (int n = 0; n < 2; ++n) for (int k = 0; k < 2; ++k) \
    dst[n][k] = *reinterpret_cast<const bf16x8*>((char*)SB(b, h) + g_lds_byte(wc * 32 + n * 16 + fr, k * 32 + fq * 8))
#define MMA(ai, bj, At_, Bt_) do { __builtin_amdgcn_s_setprio(1); \
    for (int m = 0; m < 4; ++m) for (int n = 0; n < 2; ++n) for (int k = 0; k < 2; ++k) \
      acc[ai][bj][m][n] = F16 ? __builtin_amdgcn_mfma_f32_16x16x32_f16(__builtin_bit_cast(h8_t, At_[m][k]), __builtin_bit_cast(h8_t, Bt_[n][k]), acc[ai][bj][m][n], 0, 0, 0) \
                              : __builtin_amdgcn_mfma_f32_16x16x32_bf16(At_[m][k], Bt_[n][k], acc[ai][bj][m][n], 0, 0, 0); \
    __builtin_amdgcn_s_setprio(0); } while (0)
#define WAIT_V(n) asm volatile("s_waitcnt vmcnt(" #n ")" ::: "memory")
#define WAIT_L(n) asm volatile("s_waitcnt lgkmcnt(" #n ")" ::: "memory")
#define BAR __builtin_amdgcn_s_barrier()
#define SCHED __builtin_amdgcn_sched_barrier(0)
  const int wid = tid >> 6, lane = tid & 63, wr = wid >> 2, wc = wid & 3, fr = lane & 15, fq = lane >> 4;
  unsigned so0, so1;
  { int r_, c_; g_stage_rc(tid * 16, r_, c_); so0 = (unsigned)(r_ * K + c_); g_stage_rc(tid * 16 + 8192, r_, c_); so1 = (unsigned)(r_ * K + c_); }
  f32x4 acc[2][2][4][2] = {};
  bf16x8 At[4][2], B0[2][2], B1[2][2];
  const int nt = K / G_BK;
  STAGE(SB(0, 0), Bt, bcol, 0); STAGE(SA(0, 0), A, brow, 0);
  STAGE(SB(0, 1), Bt, bcol + G_HALF, 0); STAGE(SA(0, 1), A, brow + G_HALF, 0);
  if (wr == 1) BAR;
  WAIT_V(4); BAR;
  STAGE(SB(1, 0), Bt, bcol, 1); STAGE(SA(1, 0), A, brow, 1); STAGE(SB(1, 1), Bt, bcol + G_HALF, 1);
  WAIT_V(6); BAR;
  for (int t = 0; t < nt - 2; t += 2) {
    LDB(B0, 0, 0); SCHED; LDA(At, 0, 0); STAGE(SA(1, 1), A, brow + G_HALF, t + 1);
    WAIT_L(8); BAR; WAIT_L(0); MMA(0, 0, At, B0); BAR; SCHED;
    LDB(B1, 0, 1); STAGE(SB(0, 0), Bt, bcol, t + 2);
    BAR; WAIT_L(0); MMA(0, 1, At, B1); BAR;
    LDA(At, 0, 1); STAGE(SA(0, 0), A, brow, t + 2);
    BAR; WAIT_L(0); MMA(1, 0, At, B0); BAR; SCHED;
    STAGE(SB(0, 1), Bt, bcol + G_HALF, t + 2);
    WAIT_V(6); BAR; MMA(1, 1, At, B1); BAR;
    LDB(B0, 1, 0); SCHED; LDA(At, 1, 0); STAGE(SA(0, 1), A, brow + G_HALF, t + 2);
    WAIT_L(8); BAR; WAIT_L(0); MMA(0, 0, At, B0); BAR; SCHED;
    LDB(B1, 1, 1); STAGE(SB(1, 0), Bt, bcol, t + 3);
    BAR; WAIT_L(0); MMA(0, 1, At, B1); BAR;
    LDA(At, 1, 1); STAGE(SA(1, 0), A, brow, t + 3);
    BAR; WAIT_L(0); MMA(1, 0, At, B0); BAR; SCHED;
    STAGE(SB(1, 1), Bt, bcol + G_HALF, t + 3);
    WAIT_V(6); BAR; MMA(1, 1, At, B1); BAR;
  }
  { LDB(B0, 0, 0); LDA(At, 0, 0); STAGE(SA(1, 1), A, brow + G_HALF, nt - 1);
    BAR; WAIT_L(0); MMA(0, 0, At, B0); BAR;
    LDB(B1, 0, 1); BAR; WAIT_L(0); MMA(0, 1, At, B1); BAR;
    LDA(At, 0, 1); WAIT_V(4); BAR; WAIT_L(0); MMA(1, 0, At, B0); MMA(1, 1, At, B1); BAR; }
  { LDB(B0, 1, 0); LDA(At, 1, 0); WAIT_V(2); BAR; WAIT_L(0); MMA(0, 0, At, B0); BAR;
    LDB(B1, 1, 1); WAIT_V(0); BAR; WAIT_L(0); MMA(0, 1, At, B1); BAR;
    LDA(At, 1, 1); BAR; WAIT_L(0); MMA(1, 0, At, B0); MMA(1, 1, At, B1); BAR; }
  if (wr == 0) BAR;
  ef(brow + wr * 64, bcol + wc * 32, fr, fq, acc);
  __syncthreads();
#undef SA
#undef SB
#undef STAGE
#undef LDA
#undef LDB
#undef MMA
#undef WAIT_V
#undef WAIT_L
#undef BAR
#undef SCHED
}
DI void g_tile_map(int wgid, int nM, int nN, int& pm, int& pn) {
  const int nwg = nM * nN;
  { int q = nwg / 8, r = nwg % 8, xcd = wgid % 8, off = wgid / 8; wgid = (xcd < r ? xcd * (q + 1) : r * (q + 1) + (xcd - r) * q) + off; }
  const int nig = 8 * nN, gid = wgid / nig, fm = gid * 8, gsz = min(nM - fm, 8);
  pm = fm + ((wgid % nig) % gsz); pn = (wgid % nig) / gsz;
}

struct Epi256Plain {
  u16* out; int ldo; int act;
  DI void operator()(int f0, int t0, int fr, int fq, f32x4 (&acc)[2][2][4][2]) const {
    const int fo = (fq & 1) ? 16 + 4 * (fq - 1) : 4 * fq;
#pragma unroll
    for (int ai = 0; ai < 2; ai++)
#pragma unroll
      for (int bj = 0; bj < 2; bj++)
#pragma unroll
        for (int n = 0; n < 2; n++) {
          const size_t token = (size_t)(t0 + bj * 128 + n * 16 + fr);
#pragma unroll
          for (int mp = 0; mp < 2; mp++) {
            unsigned pa[2], pb[2];
#pragma unroll
            for (int e = 0; e < 2; e++) {
              const int m = mp * 2 + e;
              float v[4];
#pragma unroll
              for (int j = 0; j < 4; j++) { float x = acc[ai][bj][m][n][j]; if (act == 1) { x = fmaxf(x, 0.f); x = x * x; } v[j] = x; }
              if (e == 0) { pa[0] = pack2(v[0], v[1]); pa[1] = pack2(v[2], v[3]); } else { pb[0] = pack2(v[0], v[1]); pb[1] = pack2(v[2], v[3]); }
            }
            auto r0 = __builtin_amdgcn_permlane16_swap(pa[0], pb[0], false, false);
            auto r1 = __builtin_amdgcn_permlane16_swap(pa[1], pb[1], false, false);
            uint4 pk; pk.x = r0[0]; pk.y = r1[0]; pk.z = r0[1]; pk.w = r1[1];
            *(uint4*)(out + token * ldo + f0 + ai * 128 + mp * 32 + fo) = pk;
          }
        }
  }
};

struct Epi256InProj {
  u16* proj; u16* vts; u16* vtw; const float* cs; const float* sn;
  DI void operator()(int f0, int t0, int fr, int fq, f32x4 (&acc)[2][2][4][2]) const {
#pragma unroll
    for (int ai = 0; ai < 2; ai++) {
      const int fb = f0 + ai * 128;
      if (fb >= PW) continue;
      const bool isrope = (fb >= 1024 && fb < 1664) || (fb >= 1792 && fb < 1920) || (fb >= 2048 && fb < 2176);
      const float scale = (fb >= 1024 && fb < 1536) ? 0.125f : 1.f;
      const bool isvts = (fb >= 1920 && fb < 2048), isvtw = (fb >= 2176 && fb < 2304);
#pragma unroll
      for (int bj = 0; bj < 2; bj++)
#pragma unroll
        for (int n = 0; n < 2; n++) {
          const int token = t0 + bj * 128 + n * 16 + fr;
          if (isrope) {
#pragma unroll
            for (int m = 0; m < 2; m++) {
              const int d0 = m * 16 + fq * 4;
              const float4 c4 = *(const float4*)(cs + (size_t)token * 32 + d0);
              const float4 s4 = *(const float4*)(sn + (size_t)token * 32 + d0);
              const float cc[4] = {c4.x, c4.y, c4.z, c4.w}, ss[4] = {s4.x, s4.y, s4.z, s4.w};
#pragma unroll
              for (int j = 0; j < 4; j++) {
                const float a1 = acc[ai][bj][m][n][j], a2 = acc[ai][bj][m + 2][n][j];
                acc[ai][bj][m][n][j] = (a1 * cc[j] - a2 * ss[j]) * scale;
                acc[ai][bj][m + 2][n][j] = (a2 * cc[j] + a1 * ss[j]) * scale;
              }
            }
          }
          if (isvts || isvtw) {
            const int b = token / S_, s = token % S_;
            const int hk = ((fb - (isvts ? 1920 : 2176)) >> 6);
            u16* vt = (isvts ? vts : vtw) + (size_t)((b * 2 + hk) * 64) * S_ + s;
#pragma unroll
            for (int m = 0; m < 4; m++)
#pragma unroll
              for (int j = 0; j < 4; j++) vt[(size_t)(m * 16 + fq * 4 + j) * S_] = f2bf(acc[ai][bj][m][n][j]);
          } else {
            const int fo = (fq & 1) ? 16 + 4 * (fq - 1) : 4 * fq;
#pragma unroll
            for (int mp = 0; mp < 2; mp++) {
              const unsigned a0 = pack2(acc[ai][bj][2 * mp][n][0], acc[ai][bj][2 * mp][n][1]), a1 = pack2(acc[ai][bj][2 * mp][n][2], acc[ai][bj][2 * mp][n][3]);
              const unsigned b0 = pack2(acc[ai][bj][2 * mp + 1][n][0], acc[ai][bj][2 * mp + 1][n][1]), b1 = pack2(acc[ai][bj][2 * mp + 1][n][2], acc[ai][bj][2 * mp + 1][n][3]);
              auto r0 = __builtin_amdgcn_permlane16_swap(a0, b0, false, false);
              auto r1 = __builtin_amdgcn_permlane16_swap(a1, b1, false, false);
              uint4 pk; pk.x = r0[0]; pk.y = r1[0]; pk.z = r0[1]; pk.w = r1[1];
              *(uint4*)(proj + (size_t)token * PW + fb + mp * 32 + fo) = pk;
            }
          }
        }
    }
  }
};

DI void transpose_tile(const float* __restrict__ W, int K, int N, u16* __restrict__ dst, int kt, int nt_, char* smem) {
  float* tile = (float*)smem;
  const int tid = tidx();
  const int k0 = kt * 64, n0 = nt_ * 64;
  {
    const int r = tid >> 4, c4 = (tid & 15) * 4;
#pragma unroll
    for (int rr = 0; rr < 2; rr++) {
      const int k = r + rr * 32;
      float4 v = make_float4(0.f, 0.f, 0.f, 0.f);
      if (n0 + c4 < N) v = *(const float4*)(W + (size_t)(k0 + k) * N + n0 + c4);
      tile[k * 65 + c4] = v.x; tile[k * 65 + c4 + 1] = v.y; tile[k * 65 + c4 + 2] = v.z; tile[k * 65 + c4 + 3] = v.w;
    }
  }
  __syncthreads();
  {
    const int n = tid >> 3, k8 = (tid & 7) * 8;
    uint4 o;
    o.x = pack2(tile[(k8 + 0) * 65 + n], tile[(k8 + 1) * 65 + n]);
    o.y = pack2(tile[(k8 + 2) * 65 + n], tile[(k8 + 3) * 65 + n]);
    o.z = pack2(tile[(k8 + 4) * 65 + n], tile[(k8 + 5) * 65 + n]);
    o.w = pack2(tile[(k8 + 6) * 65 + n], tile[(k8 + 7) * 65 + n]);
    *(uint4*)(dst + (size_t)(n0 + n) * K + k0 + k8) = o;
  }
  __syncthreads();
}

struct TJob { const float* W; int K, N; u16* dst; int kt, nt; int f16; };
DI void transpose_pair(const TJob& ja, const TJob& jb, char* smem) {
  float* tile = (float*)smem;
  const int tid = tidx();
  const int r = tid >> 4, c4 = (tid & 15) * 4;
  float4 va[2], vb[2];
#pragma unroll
  for (int rr = 0; rr < 2; rr++) {
    const int k = r + rr * 32;
    va[rr] = make_float4(0.f, 0.f, 0.f, 0.f); vb[rr] = va[rr];
    if (ja.nt * 64 + c4 < ja.N) va[rr] = *(const float4*)(ja.W + (size_t)(ja.kt * 64 + k) * ja.N + ja.nt * 64 + c4);
    if (jb.nt * 64 + c4 < jb.N) vb[rr] = *(const float4*)(jb.W + (size_t)(jb.kt * 64 + k) * jb.N + jb.nt * 64 + c4);
  }
#pragma unroll
  for (int rr = 0; rr < 2; rr++) {
    const int k = r + rr * 32;
    float* ta = tile + k * 65 + c4; float* tb = ta + 64 * 65;
    ta[0] = va[rr].x; ta[1] = va[rr].y; ta[2] = va[rr].z; ta[3] = va[rr].w;
    tb[0] = vb[rr].x; tb[1] = vb[rr].y; tb[2] = vb[rr].z; tb[3] = vb[rr].w;
  }
  __syncthreads();
  {
    const int n = tid >> 3, k8 = (tid & 7) * 8;
#pragma unroll
    for (int e = 0; e < 2; e++) {
      const float* t = tile + e * 64 * 65;
      const TJob& j = e ? jb : ja;
      uint4 o;
      if (j.f16) {
        o.x = pack2h(t[(k8 + 0) * 65 + n], t[(k8 + 1) * 65 + n]);
        o.y = pack2h(t[(k8 + 2) * 65 + n], t[(k8 + 3) * 65 + n]);
        o.z = pack2h(t[(k8 + 4) * 65 + n], t[(k8 + 5) * 65 + n]);
        o.w = pack2h(t[(k8 + 6) * 65 + n], t[(k8 + 7) * 65 + n]);
      } else {
        o.x = pack2(t[(k8 + 0) * 65 + n], t[(k8 + 1) * 65 + n]);
        o.y = pack2(t[(k8 + 2) * 65 + n], t[(k8 + 3) * 65 + n]);
        o.z = pack2(t[(k8 + 4) * 65 + n], t[(k8 + 5) * 65 + n]);
        o.w = pack2(t[(k8 + 6) * 65 + n], t[(k8 + 7) * 65 + n]);
      }
      *(uint4*)(j.dst + (size_t)(j.nt * 64 + n) * j.K + j.kt * 64 + k8) = o;
    }
  }
  __syncthreads();
}

template <int NB, bool SILU>
DI void gemv_tile(const float* __restrict__ a, int lda, const float* __restrict__ W, int K, int N, int n0, const float* bias, float* out, int ldo, char* smem) {
  float* red = (float*)smem;
  const int tid = tidx(), nn = tid & 63, ks = tid >> 6;
  float acc[NB];
#pragma unroll
  for (int r = 0; r < NB; r++) acc[r] = 0.f;
  const int kl = K / 8;
  for (int k = ks * kl; k < (ks + 1) * kl; k++) {
    const float w = W[(size_t)k * N + n0 + nn];
#pragma unroll
    for (int r = 0; r < NB; r++) { float av = a[r * lda + k]; if (SILU) av = silu(av); acc[r] += av * w; }
  }
#pragma unroll
  for (int r = 0; r < NB; r++) red[(ks * NB + r) * 64 + nn] = acc[r];
  __syncthreads();
  if (tid < NB * 64) {
    const int r = tid >> 6;
    float s = 0.f;
#pragma unroll
    for (int j = 0; j < 8; j++) s += red[(j * NB + r) * 64 + nn];
    if (bias) s += bias[n0 + nn];
    out[r * ldo + n0 + nn] = s;
  }
  __syncthreads();
}

constexpr int TR_PER_LAYER = 768 + 256 + 1024 + 1024 + 128 + 128 + 8 + 8;
constexpr int PREP_TR = 4 * TR_PER_LAYER;
constexpr int PREP_MOD = 4 * 96;
constexpr int PREP_CB = 4 * 2 * 4;
constexpr int PREP_ROPE = 512;
constexpr int PREP_WSB = 128;
constexpr int PREP_ITEMS = PREP_TR + PREP_MOD + PREP_CB + PREP_ROPE + PREP_WSB + 1;

DI TJob decode_tr(const P& p, int item) {
  const int l = item / TR_PER_LAYER; int r = item % TR_PER_LAYER;
  TJob j; j.f16 = 0;
  if (r < 768) { j.f16 = 1; j.W = p.in[3] + (size_t)l * 1024 * 2840; j.K = 1024; j.N = 2840; j.dst = (u16*)(p.ws + OFF_WIN) + (size_t)l * NPI * 1024; j.kt = r / 48; j.nt = r % 48; return j; }
  r -= 768;
  if (r < 256) { j.W = p.in[4] + (size_t)l * 1024 * 1024; j.K = 1024; j.N = 1024; j.dst = (u16*)(p.ws + OFF_WO) + (size_t)l * 1024 * 1024; j.kt = r / 16; j.nt = r % 16; return j; }
  r -= 256;
  if (r < 1024) { j.f16 = 1; j.W = p.in[17] + (size_t)l * 1024 * 4096; j.K = 1024; j.N = 4096; j.dst = (u16*)(p.ws + OFF_FF1) + (size_t)l * 4096 * 1024; j.kt = r / 64; j.nt = r % 64; return j; }
  r -= 1024;
  if (r < 1024) { j.W = p.in[18] + (size_t)l * 4096 * 1024; j.K = 4096; j.N = 1024; j.dst = (u16*)(p.ws + OFF_FF2) + (size_t)l * 1024 * 4096; j.kt = r / 16; j.nt = r % 16; return j; }
  r -= 1024;
  if (r < 256) { const int kv = r >> 7; r &= 127; j.W = p.in[kv ? 11 : 8] + (size_t)l * 2048 * 256; j.K = 2048; j.N = 256; j.dst = (u16*)(p.ws + OFF_CW1) + (size_t)(l * 2 + kv) * 256 * 2048; j.kt = r / 4; j.nt = r % 4; return j; }
  r -= 256;
  { const int kv = r >> 3; r &= 7; j.W = p.in[kv ? 12 : 9] + (size_t)l * 256 * 64; j.K = 256; j.N = 64; j.dst = (u16*)(p.ws + OFF_CW2) + (size_t)(l * 2 + kv) * 128 * 256; j.kt = r / 2; j.nt = r % 2; return j; }
}

DI void prep_item(const P& p, int item, char* smem) {
  const int tid = tidx();
  if (item < PREP_TR) { const TJob j = decode_tr(p, item); transpose_pair(j, j, smem); return; }
  item -= PREP_TR;
  if (item < PREP_MOD) {
    const int l = item / 96, nt_ = item % 96;
    gemv_tile<4, true>(p.in[1], 1024, p.in[19] + (size_t)l * 1024 * 6144, 1024, 6144, nt_ * 64, p.in[20] + l * 6144,
                       (float*)(p.ws + OFF_MOD) + (size_t)l * 4 * 6144, 6144, smem);
    return;
  }
  item -= PREP_MOD;
  if (item < PREP_CB) {
    const int l = item >> 3, kv = (item >> 2) & 1, nt_ = item & 3;
    gemv_tile<1, false>(p.in[kv ? 10 : 7] + (size_t)l * 2048, 2048, p.in[kv ? 11 : 8] + (size_t)l * 2048 * 256, 2048, 256, nt_ * 64, nullptr,
                        (float*)(p.ws + OFF_CB) + (l * 2 + kv) * 256, 256, smem);
    return;
  }
  item -= PREP_CB;
  if (item < PREP_ROPE) {
    float* cs = (float*)(p.ws + OFF_COS); float* sn = (float*)(p.ws + OFF_SIN);
    const int* pos = (const int*)p.in[2];
#pragma unroll
    for (int j = 0; j < 4; j++) {
      const int idx = item * 2048 + j * 512 + tid;
      const int tok = idx >> 5, i = idx & 31;
      const double ang = (double)pos[tok] * p.invf[i];
      const double qd = rint(ang * p.cf[13]);
      const double r = (ang - qd * p.cf[14]) - qd * p.cf[15];
      const double r2 = r * r;
      const double sr = r * (1.0 + r2 * (p.cf[0] + r2 * (p.cf[1] + r2 * (p.cf[2] + r2 * (p.cf[3] + r2 * (p.cf[4] + r2 * p.cf[5]))))));
      const double cr = 1.0 + r2 * (p.cf[6] + r2 * (p.cf[7] + r2 * (p.cf[8] + r2 * (p.cf[9] + r2 * (p.cf[10] + r2 * (p.cf[11] + r2 * p.cf[12]))))));
      const int qi = ((int)((long long)qd)) & 3;
      double s_, c_;
      if (qi == 0) { s_ = sr; c_ = cr; } else if (qi == 1) { s_ = cr; c_ = -sr; } else if (qi == 2) { s_ = -sr; c_ = -cr; } else { s_ = -cr; c_ = sr; }
      cs[idx] = (float)c_; sn[idx] = (float)s_;
    }
    return;
  }
  item -= PREP_ROPE;
  if (item < PREP_WSB) {
    const float* src = p.in[15];
    u16* dst = (u16*)(p.ws + OFF_WSB);
#pragma unroll
    for (int j = 0; j < 4; j++) {
      const int idx = item * 2048 + j * 512 + tid;
      const int t_ = (idx >> 7) & 127, s_ = idx & 127;
      dst[idx] = f2bf(s_ <= t_ ? src[idx] : 0.f);
    }
    return;
  }
  if (tid < 256) {
    const float* lbr = p.in[5];
    float v[4], m = -1e30f;
#pragma unroll
    for (int l = 0; l < 4; l++) { v[l] = lbr[l * 256 + tid]; m = fmaxf(m, v[l]); }
    float s = 0.f;
#pragma unroll
    for (int l = 0; l < 4; l++) { v[l] = __expf(v[l] - m); s += v[l]; }
    float* lb = (float*)(p.ws + OFF_LB);
    float cum = 0.f;
#pragma unroll
    for (int l = 0; l < 4; l++) { if (l > 0) cum += v[l] / s; lb[l * 256 + tid] = cum; }
  }
}

DI void ln_rows(const P& p, int layer, int mode, int item) {
  const int tid_ = tidx(); const int lane = tid_ & 63, wid = tid_ >> 6;
  const int row = (mode == 0) ? item * 8 + wid : item * 32 + wid * 4;
  const int b = row / S_;
  const float* mod = (const float*)(p.ws + OFF_MOD);
  u16* hb = (u16*)(p.ws + OFF_H) + (size_t)row * 1024;
  if (mode == 0) {
    const float* x = p.in[0] + (size_t)row * 1024;
    const float* md = mod + (size_t)(0 * 4 + b) * 6144;
#pragma unroll
    for (int i = 0; i < 4; i++) {
      const int col = i * 256 + lane * 4;
      const float4 xv = *(const float4*)(x + col);
      const float4 sh = *(const float4*)(md + col), sc = *(const float4*)(md + 1024 + col);
      uint2 pk; pk.x = pack2h(xv.x * (1.f + sc.x) + sh.x, xv.y * (1.f + sc.y) + sh.y); pk.y = pack2h(xv.z * (1.f + sc.z) + sh.z, xv.w * (1.f + sc.w) + sh.w);
      *(uint2*)(hb + col) = pk;
    }
    return;
  }
  constexpr int NR = 4;
  const float* lw = p.in[mode == 1 ? 21 : 23] + layer * 1024;
  const float* lbias = p.in[mode == 1 ? 22 : 24] + layer * 1024;
  const bool has_next = !(mode == 2 && layer == 3);
  const bool from_input = (layer == 0 && mode == 1);
  const u16* ybuf = (mode == 2 && layer == 3) ? (const u16*)(p.ws + OFF_YL) : (const u16*)p.out;
  const float* mdl = mod + (size_t)(layer * 4 + b) * 6144;
  const float* gvec = mdl + (mode == 1 ? 2 : 5) * 1024;
  const float* mprev = mdl + (mode == 1 ? 0 : 3) * 1024;
  const float* mdn = (mode == 1) ? mdl + 3 * 1024 : mod + (size_t)((layer + 1) * 4 + b) * 6144;
  float v[NR][16];
  float s[NR];
#pragma unroll
  for (int rr = 0; rr < NR; rr++) s[rr] = 0.f;
#pragma unroll
  for (int i = 0; i < 2; i++) {
    const int col = i * 512 + lane * 8;
    float gg[8], shv[8], isc[8];
    { const float4 a = *(const float4*)(gvec + col), c2 = *(const float4*)(gvec + col + 4);
      gg[0] = 1.f + a.x; gg[1] = 1.f + a.y; gg[2] = 1.f + a.z; gg[3] = 1.f + a.w; gg[4] = 1.f + c2.x; gg[5] = 1.f + c2.y; gg[6] = 1.f + c2.z; gg[7] = 1.f + c2.w; }
    if (!from_input) {
      const float4 a = *(const float4*)(mprev + col), c2 = *(const float4*)(mprev + col + 4);
      const float4 e = *(const float4*)(mprev + 1024 + col), f = *(const float4*)(mprev + 1024 + col + 4);
      shv[0] = a.x; shv[1] = a.y; shv[2] = a.z; shv[3] = a.w; shv[4] = c2.x; shv[5] = c2.y; shv[6] = c2.z; shv[7] = c2.w;
      isc[0] = 1.f / (1.f + e.x); isc[1] = 1.f / (1.f + e.y); isc[2] = 1.f / (1.f + e.z); isc[3] = 1.f / (1.f + e.w);
      isc[4] = 1.f / (1.f + f.x); isc[5] = 1.f / (1.f + f.y); isc[6] = 1.f / (1.f + f.z); isc[7] = 1.f / (1.f + f.w);
    } else {
#pragma unroll
      for (int j = 0; j < 8; j++) { shv[j] = 0.f; isc[j] = 1.f; }
    }
#pragma unroll
    for (int rr = 0; rr < NR; rr++) {
      const size_t r = (size_t)(row + rr);
      float xv[8], yv[8];
      if (from_input) {
        const float4 a = *(const float4*)(p.in[0] + r * 1024 + col), c2 = *(const float4*)(p.in[0] + r * 1024 + col + 4);
        xv[0] = a.x; xv[1] = a.y; xv[2] = a.z; xv[3] = a.w; xv[4] = c2.x; xv[5] = c2.y; xv[6] = c2.z; xv[7] = c2.w;
      } else {
        const uint4 hr = *(const uint4*)((const u16*)(p.ws + OFF_H) + r * 1024 + col);
        xv[0] = hlo2f(hr.x); xv[1] = hhi2f(hr.x); xv[2] = hlo2f(hr.y); xv[3] = hhi2f(hr.y);
        xv[4] = hlo2f(hr.z); xv[5] = hhi2f(hr.z); xv[6] = hlo2f(hr.w); xv[7] = hhi2f(hr.w);
#pragma unroll
        for (int j = 0; j < 8; j++) xv[j] = (xv[j] - shv[j]) * isc[j];
      }
      unpack8(*(const uint4*)(ybuf + r * 1024 + col), yv);
#pragma unroll
      for (int j = 0; j < 8; j++) { const float t_ = DN_ALPHA * xv[j] + gg[j] * yv[j]; v[rr][i * 8 + j] = t_; s[rr] += t_; }
    }
  }
  float mu[NR], rs[NR];
#pragma unroll
  for (int rr = 0; rr < NR; rr++) mu[rr] = s[rr];
#pragma unroll
  for (int o = 32; o > 0; o >>= 1) {
#pragma unroll
    for (int rr = 0; rr < NR; rr++) mu[rr] += __shfl_xor(mu[rr], o);
  }
#pragma unroll
  for (int rr = 0; rr < NR; rr++) {
    mu[rr] *= (1.f / 1024.f);
    float s2 = 0.f;
#pragma unroll
    for (int i = 0; i < 16; i++) { v[rr][i] -= mu[rr]; s2 += v[rr][i] * v[rr][i]; }
    rs[rr] = s2;
  }
#pragma unroll
  for (int o = 32; o > 0; o >>= 1) {
#pragma unroll
    for (int rr = 0; rr < NR; rr++) rs[rr] += __shfl_xor(rs[rr], o);
  }
#pragma unroll
  for (int rr = 0; rr < NR; rr++) rs[rr] = rsqrtf(rs[rr] * (1.f / 1024.f) + 1e-5f);
#pragma unroll
  for (int i = 0; i < 2; i++) {
    const int col = i * 512 + lane * 8;
    float wv[8], bv[8], shn[8], scn[8];
    { const float4 a = *(const float4*)(lw + col), c2 = *(const float4*)(lw + col + 4), e = *(const float4*)(lbias + col), f = *(const float4*)(lbias + col + 4);
      wv[0] = a.x; wv[1] = a.y; wv[2] = a.z; wv[3] = a.w; wv[4] = c2.x; wv[5] = c2.y; wv[6] = c2.z; wv[7] = c2.w;
      bv[0] = e.x; bv[1] = e.y; bv[2] = e.z; bv[3] = e.w; bv[4] = f.x; bv[5] = f.y; bv[6] = f.z; bv[7] = f.w; }
    if (has_next) {
      const float4 a = *(const float4*)(mdn + col), c2 = *(const float4*)(mdn + col + 4), e = *(const float4*)(mdn + 1024 + col), f = *(const float4*)(mdn + 1024 + col + 4);
      shn[0] = a.x; shn[1] = a.y; shn[2] = a.z; shn[3] = a.w; shn[4] = c2.x; shn[5] = c2.y; shn[6] = c2.z; shn[7] = c2.w;
      scn[0] = 1.f + e.x; scn[1] = 1.f + e.y; scn[2] = 1.f + e.z; scn[3] = 1.f + e.w; scn[4] = 1.f + f.x; scn[5] = 1.f + f.y; scn[6] = 1.f + f.z; scn[7] = 1.f + f.w;
    } else {
#pragma unroll
      for (int j = 0; j < 8; j++) { shn[j] = 0.f; scn[j] = 1.f; }
    }
#pragma unroll
    for (int rr = 0; rr < NR; rr++) {
      const size_t r = (size_t)(row + rr);
      float o[8];
#pragma unroll
      for (int j = 0; j < 8; j++) o[j] = v[rr][i * 8 + j] * rs[rr] * wv[j] + bv[j];
      if (has_next) {
        uint4 pk;
        pk.x = pack2h(o[0] * scn[0] + shn[0], o[1] * scn[1] + shn[1]); pk.y = pack2h(o[2] * scn[2] + shn[2], o[3] * scn[3] + shn[3]);
        pk.z = pack2h(o[4] * scn[4] + shn[4], o[5] * scn[5] + shn[5]); pk.w = pack2h(o[6] * scn[6] + shn[6], o[7] * scn[7] + shn[7]);
        *(uint4*)((u16*)(p.ws + OFF_H) + r * 1024 + col) = pk;
      } else {
        *(float4*)(p.out + r * 1024 + col) = make_float4(o[0], o[1], o[2], o[3]);
        *(float4*)(p.out + r * 1024 + col + 4) = make_float4(o[4], o[5], o[6], o[7]);
      }
    }
  }
}

DI void hgrn_item(const P& p, int layer, int item, int mode, char* smem) {
  const int hh = item & 3, c = (item >> 2) & 127, b = item >> 9;
  const int bh = b * 4 + hh;
  const int tid = tidx();
  float* Bf = (float*)smem;
  float* A1 = Bf + 4096;
  float* At = A1 + 4160;
  float* A2 = At + 4160;
  float* Vs = A2 + 4096;
  float* Sp = Vs + 4096;
  float* seg = Sp + 4096;
  constexpr int HK = 72;
  u16* QdB = (u16*)(A1);
  u16* KdB = QdB + 64 * HK;
  u16* AtB = KdB + 64 * HK;
  u16* VtB = AtB + 64 * HK;
  u16* SpT = VtB + 64 * HK;
  const u16* pr = (const u16*)(p.ws + OFF_BIG) + (size_t)(b * S_ + c * 64) * PW + hh * 64;
  const float* lbp = (const float*)(p.ws + OFF_LB) + layer * 256 + hh * 64;
  float* stp = (float*)(p.ws + OFF_ST) + (size_t)(bh * 128 + c) * 4096;
  const int s = tid >> 3, k8 = (tid & 7) * 8;
  float z[8];
  {
    float vv[8];
    unpack8(*(const uint4*)(pr + (size_t)s * PW + 256 + k8), z);
    unpack8(*(const uint4*)(pr + (size_t)s * PW + 512 + k8), vv);
#pragma unroll
    for (int j = 0; j < 8; j++) {
      const float lb = lbp[k8 + j];
      const float f = lb + (1.f - lb) * sigm(z[j]);
      Bf[s * 64 + k8 + j] = __logf(fmaxf(f, 1e-30f));
      VtB[(k8 + j) * HK + s] = f2bf(vv[j]);
    }
  }
  __syncthreads();
  {
    const int k = tid & 63, sg = tid >> 6;
    float run = 0.f, loc[8];
#pragma unroll
    for (int i = 0; i < 8; i++) { run += Bf[(sg * 8 + i) * 64 + k]; loc[i] = run; }
    seg[sg * 64 + k] = run;
    __syncthreads();
    float pre = 0.f;
    for (int j = 0; j < sg; j++) pre += seg[j * 64 + k];
#pragma unroll
    for (int i = 0; i < 8; i++) Bf[(sg * 8 + i) * 64 + k] = loc[i] + pre;
  }
  __syncthreads();
  if (mode == 0) {
    u16* KdT = KdB;
#pragma unroll
    for (int j = 0; j < 8; j++) {
      const int k = k8 + j;
      const float lb = lbp[k];
      const float kk = (1.f - lb) * sigm(-z[j]);
      KdT[k * HK + s] = f2bf(kk * __expf(Bf[63 * 64 + k] - Bf[s * 64 + k]));
    }
    __syncthreads();
    const int lane = tid & 63, wid = tid >> 6, m = lane & 15, lg = lane >> 4;
    const int kt = wid >> 1;
#pragma unroll
    for (int q = 0; q < 2; q++) {
      const int vt = (wid & 1) * 2 + q;
      f32x4 acc = {0.f, 0.f, 0.f, 0.f};
#pragma unroll
      for (int ks = 0; ks < 2; ks++) {
        const bf16x8 av = *(const bf16x8*)(VtB + (16 * vt + m) * HK + 32 * ks + 8 * lg);
        const bf16x8 bk = *(const bf16x8*)(KdT + (16 * kt + m) * HK + 32 * ks + 8 * lg);
        acc = mfma16(av, bk, acc);
      }
      *(float4*)(stp + (16 * kt + m) * 64 + 16 * vt + 4 * lg) = make_float4(acc[0], acc[1], acc[2], acc[3]);
    }
    if (tid < 64) ((float*)(p.ws + OFF_DEC))[(size_t)(bh * 128 + c) * 64 + tid] = __expf(Bf[63 * 64 + tid]);
    __syncthreads();
    return;
  }
  {
    float qv[8];
    unpack8(*(const uint4*)(pr + (size_t)s * PW + k8), qv);
    float qd[8], kd[8];
#pragma unroll
    for (int j = 0; j < 8; j++) {
      const int k = k8 + j;
      const float lb = lbp[k];
      const float bm = Bf[31 * 64 + k], bb = Bf[s * 64 + k];
      qd[j] = silu(qv[j]) * __expf(bb - bm);
      kd[j] = (1.f - lb) * sigm(-z[j]) * __expf(bm - bb);
    }
    uint4 pq, pk_;
    pq.x = pack2(qd[0], qd[1]); pq.y = pack2(qd[2], qd[3]); pq.z = pack2(qd[4], qd[5]); pq.w = pack2(qd[6], qd[7]);
    pk_.x = pack2(kd[0], kd[1]); pk_.y = pack2(kd[2], kd[3]); pk_.z = pack2(kd[4], kd[5]); pk_.w = pack2(kd[6], kd[7]);
    *(uint4*)(QdB + s * HK + k8) = pq;
    *(uint4*)(KdB + s * HK + k8) = pk_;
    const int k = tid >> 3, v0 = (tid & 7) * 8;
    const float e = __expf(Bf[31 * 64 + k]);
    const float4 sa = *(const float4*)(stp + k * 64 + v0), sb = *(const float4*)(stp + k * 64 + v0 + 4);
    const float sv[8] = {sa.x, sa.y, sa.z, sa.w, sb.x, sb.y, sb.z, sb.w};
#pragma unroll
    for (int i = 0; i < 8; i++) SpT[(v0 + i) * HK + k] = f2bf(sv[i] * e);
  }
  __syncthreads();
  const int lane = tid & 63, wid = tid >> 6, m = lane & 15, lg = lane >> 4;
  {
    const int mt = wid >> 1;
#pragma unroll
    for (int q = 0; q < 2; q++) {
      const int nt = (wid & 1) * 2 + q;
      f32x4 acc = {0.f, 0.f, 0.f, 0.f};
#pragma unroll
      for (int ks = 0; ks < 2; ks++) {
        const bf16x8 af = *(const bf16x8*)(KdB + (16 * nt + m) * HK + 32 * ks + 8 * lg);
        const bf16x8 bfr = *(const bf16x8*)(QdB + (16 * mt + m) * HK + 32 * ks + 8 * lg);
        acc = mfma16(af, bfr, acc);
      }
      const int t_ = 16 * mt + m, s0 = 16 * nt + 4 * lg;
      uint2 pk;
      pk.x = pack2(s0 + 0 <= t_ ? acc[0] : 0.f, s0 + 1 <= t_ ? acc[1] : 0.f);
      pk.y = pack2(s0 + 2 <= t_ ? acc[2] : 0.f, s0 + 3 <= t_ ? acc[3] : 0.f);
      *(uint2*)(AtB + t_ * HK + s0) = pk;
    }
  }
  __syncthreads();
  if (wid < 4) {
    const int mt = wid;
    f32x4 acc[4];
#pragma unroll
    for (int nt = 0; nt < 4; nt++) acc[nt] = (f32x4){0.f, 0.f, 0.f, 0.f};
#pragma unroll
    for (int ks = 0; ks < 2; ks++) {
      const bf16x8 ba = *(const bf16x8*)(AtB + (16 * mt + m) * HK + 32 * ks + 8 * lg);
      const bf16x8 bq = *(const bf16x8*)(QdB + (16 * mt + m) * HK + 32 * ks + 8 * lg);
#pragma unroll
      for (int nt = 0; nt < 4; nt++) {
        const bf16x8 av = *(const bf16x8*)(VtB + (16 * nt + m) * HK + 32 * ks + 8 * lg);
        const bf16x8 as_ = *(const bf16x8*)(SpT + (16 * nt + m) * HK + 32 * ks + 8 * lg);
        acc[nt] = mfma16(av, ba, acc[nt]);
        acc[nt] = mfma16(as_, bq, acc[nt]);
      }
    }
    float ssq = 0.f;
#pragma unroll
    for (int nt = 0; nt < 4; nt++) ssq += acc[nt][0] * acc[nt][0] + acc[nt][1] * acc[nt][1] + acc[nt][2] * acc[nt][2] + acc[nt][3] * acc[nt][3];
    ssq += __shfl_xor(ssq, 16); ssq += __shfl_xor(ssq, 32);
    const float rn = rsqrtf(ssq * (1.f / 64.f) + 1e-6f);
    const int t_ = 16 * mt + m;
    const float* nw = p.in[6] + layer * 64;
#pragma unroll
    for (int nt = 0; nt < 4; nt++) {
      const int v0 = 16 * nt + 4 * lg;
      const uint2 gr = *(const uint2*)(pr + (size_t)t_ * PW + 768 + v0);
      const float4 n4 = *(const float4*)(nw + v0);
      uint2 pk;
      pk.x = pack2(acc[nt][0] * rn * n4.x * silu(lo2f(gr.x)), acc[nt][1] * rn * n4.y * silu(hi2f(gr.x)));
      pk.y = pack2(acc[nt][2] * rn * n4.z * silu(lo2f(gr.y)), acc[nt][3] * rn * n4.w * silu(hi2f(gr.y)));
      *(uint2*)((u16*)(p.ws + OFF_MIX) + (size_t)(b * S_ + c * 64 + t_) * 1024 + hh * 64 + v0) = pk;
    }
  }
  __syncthreads();
}

DI void scan_item(const P& p, int item) {
  const int tid = tidx();
  if (tid >= 256) return;
  const int gid = item * 256 + tid;
  const int bh = gid >> 12, e = gid & 4095;
  float* st = (float*)(p.ws + OFF_ST) + (size_t)bh * 128 * 4096 + e;
  const float* dc = (const float*)(p.ws + OFF_DEC) + (size_t)bh * 128 * 64 + (e >> 6);
  float carry = 0.f;
  for (int c0 = 0; c0 < 128; c0 += 16) {
    float tmp[16], d[16];
#pragma unroll
    for (int j = 0; j < 16; j++) { tmp[j] = st[(size_t)(c0 + j) * 4096]; d[j] = dc[(c0 + j) * 64]; }
#pragma unroll
    for (int j = 0; j < 16; j++) { st[(size_t)(c0 + j) * 4096] = carry; carry = d[j] * carry + tmp[j]; }
  }
}

DI void gmlp_item(const P& p, int layer, int item, char* smem) {
  constexpr int KS = 136;
  const int g = item & 3, ch = (item >> 2) & 63, b = item >> 8;
  const int tid = tidx(), lane = tid & 63, wid = tid >> 6;
  u16* VnT = (u16*)smem;
  const size_t tok0 = (size_t)b * S_ + ch * 128;
  const u16* proj = (const u16*)(p.ws + OFF_BIG);
  const float* nw = p.in[13] + layer * 256;
  const float* nb = p.in[14] + layer * 256;
  for (int t4b = 0; t4b < 16; t4b += 4) {
    float v[4][4], mu[4], rs[4];
#pragma unroll
    for (int q = 0; q < 4; q++) {
      const int tl = wid * 16 + t4b + q;
      const uint2 raw = *(const uint2*)(proj + (tok0 + tl) * PW + 2584 + lane * 4);
      v[q][0] = gelu_t(lo2f(raw.x)); v[q][1] = gelu_t(hi2f(raw.x)); v[q][2] = gelu_t(lo2f(raw.y)); v[q][3] = gelu_t(hi2f(raw.y));
    }
#pragma unroll
    for (int q = 0; q < 4; q++) mu[q] = v[q][0] + v[q][1] + v[q][2] + v[q][3];
#pragma unroll
    for (int o = 32; o > 0; o >>= 1) {
#pragma unroll
      for (int q = 0; q < 4; q++) mu[q] += __shfl_xor(mu[q], o);
    }
#pragma unroll
    for (int q = 0; q < 4; q++) {
      mu[q] *= (1.f / 256.f);
      float d2 = 0.f;
#pragma unroll
      for (int j = 0; j < 4; j++) { v[q][j] -= mu[q]; d2 += v[q][j] * v[q][j]; }
      rs[q] = d2;
    }
#pragma unroll
    for (int o = 32; o > 0; o >>= 1) {
#pragma unroll
      for (int q = 0; q < 4; q++) rs[q] += __shfl_xor(rs[q], o);
    }
    if ((lane >> 4) == g) {
#pragma unroll
      for (int q = 0; q < 4; q++) {
        const int tl = wid * 16 + t4b + q;
        const float r = rsqrtf(rs[q] * (1.f / 256.f) + 1e-5f);
#pragma unroll
        for (int j = 0; j < 4; j++) { const int cch = lane * 4 + j; VnT[((lane & 15) * 4 + j) * KS + tl] = f2bf(v[q][j] * r * nw[cch] + nb[cch]); }
      }
    }
  }
  __syncthreads();
  const int tw = (wid < 4) ? wid : 11 - wid;
  const int m = lane & 15, hh = lane >> 4;
  const u16* wrow = (const u16*)(p.ws + OFF_WSB) + ((size_t)(layer * 4 + g) * 128 + 16 * tw + m) * 128 + 8 * hh;
  f32x4 acc[4];
#pragma unroll
  for (int nt = 0; nt < 4; nt++) acc[nt] = (f32x4){0.f, 0.f, 0.f, 0.f};
  const int nks = ((16 * tw + 15) >> 5) + 1;
  for (int ks = 0; ks < nks; ks++) {
    const bf16x8 wf = *(const bf16x8*)(wrow + 32 * ks);
#pragma unroll
    for (int nt = 0; nt < 4; nt++) {
      const bf16x8 vfr = *(const bf16x8*)(VnT + (16 * nt + m) * KS + 32 * ks + 8 * hh);
      acc[nt] = mfma16(vfr, wf, acc[nt]);
    }
  }
  {
    const int t_ = 16 * tw + m;
    const size_t tok = tok0 + t_;
    const float bsv = p.in[16][(size_t)(layer * 4 + g) * 128 + t_];
#pragma unroll
    for (int nt = 0; nt < 4; nt++) {
      const int c0 = 16 * nt + 4 * hh;
      const uint2 ur = *(const uint2*)(proj + tok * PW + 2328 + g * 64 + c0);
      const float u0 = gelu_t(lo2f(ur.x)), u1 = gelu_t(hi2f(ur.x)), u2 = gelu_t(lo2f(ur.y)), u3 = gelu_t(hi2f(ur.y));
      uint2 pk; pk.x = pack2(u0 * (acc[nt][0] + bsv), u1 * (acc[nt][1] + bsv)); pk.y = pack2(u2 * (acc[nt][2] + bsv), u3 * (acc[nt][3] + bsv));
      *(uint2*)((u16*)(p.ws + OFF_MIX) + tok * 1024 + 768 + g * 64 + c0) = pk;
    }
  }
  __syncthreads();
}

DI void qk_block(const u16* __restrict__ Kb, int ldk, bf16x8 q0, bf16x8 q1, f32x4 (&st)[4], int lane) {
  const int m = lane & 15, hh = lane >> 4;
#pragma unroll
  for (int i = 0; i < 4; i++) {
    const int key = 32 * (i >> 1) + 8 * (m >> 2) + 4 * (i & 1) + (m & 3);
    const u16* kp = Kb + (size_t)key * ldk + 8 * hh;
    const bf16x8 k0 = *(const bf16x8*)kp, k1 = *(const bf16x8*)(kp + 32);
    f32x4 z = {0.f, 0.f, 0.f, 0.f};
    z = mfma16(k0, q0, z);
    st[i] = mfma16(k1, q1, z);
  }
}
DI void pv_block(const u16* __restrict__ VTb, int ldv, bf16x8 p0, bf16x8 p1, f32x4 (&o)[4], int lane) {
  const int m = lane & 15, hh = lane >> 4;
#pragma unroll
  for (int mt = 0; mt < 4; mt++) {
    const u16* vp = VTb + (size_t)(mt * 16 + m) * ldv + 8 * hh;
    const bf16x8 v0 = *(const bf16x8*)vp, v1 = *(const bf16x8*)(vp + 32);
    o[mt] = mfma16(v0, p0, o[mt]);
    o[mt] = mfma16(v1, p1, o[mt]);
  }
}
DI bf16x8 packp(const f32x4& a, const f32x4& b) {
  typedef __attribute__((ext_vector_type(4))) unsigned u32x4_t;
  u32x4_t v = {pack2(a[0], a[1]), pack2(a[2], a[3]), pack2(b[0], b[1]), pack2(b[2], b[3])};
  return __builtin_bit_cast(bf16x8, v);
}
template <class MF>
DI void attn_block(const u16* Kb, int ldk, const u16* VTb, int ldv, bf16x8 q0, bf16x8 q1, float& m_run, float& l_run, f32x4 (&o)[4], MF mask, int lane) {
  f32x4 st[4];
  qk_block(Kb, ldk, q0, q1, st, lane);
  const int h = lane >> 4;
  float bm = NEGF;
#pragma unroll
  for (int i = 0; i < 4; i++)
#pragma unroll
    for (int r = 0; r < 4; r++) {
      const int kk = 32 * (i >> 1) + 8 * h + 4 * (i & 1) + r;
      const float v = mask(kk) ? st[i][r] : NEGF;
      st[i][r] = v; bm = fmaxf(bm, v);
    }
  bm = fmaxf(bm, __shfl_xor(bm, 16)); bm = fmaxf(bm, __shfl_xor(bm, 32));
  const float mn = fmaxf(m_run, bm);
  const float sc = __expf(m_run - mn);
  float ps = 0.f;
#pragma unroll
  for (int i = 0; i < 4; i++)
#pragma unroll
    for (int r = 0; r < 4; r++) {
      const float pv = (st[i][r] > -1e29f) ? __expf(st[i][r] - mn) : 0.f;
      st[i][r] = pv; ps += pv;
    }
  l_run = l_run * sc + ps; m_run = mn;
#pragma unroll
  for (int mt = 0; mt < 4; mt++) { o[mt][0] *= sc; o[mt][1] *= sc; o[mt][2] *= sc; o[mt][3] *= sc; }
  pv_block(VTb, ldv, packp(st[0], st[1]), packp(st[2], st[3]), o, lane);
}
DI unsigned long long rfl64(unsigned long long v) {
  unsigned lo = __builtin_amdgcn_readfirstlane((unsigned)v), hi = __builtin_amdgcn_readfirstlane((unsigned)(v >> 32));
  return ((unsigned long long)hi << 32) | lo;
}

DI void nsa_item(const P& p, int item, char* smem) {
  const int tid = tidx(), lane = tid & 63, wid = tid >> 6;
  const int bh = item & 7, qt = 255 - (item >> 3);
  const int b = bh >> 1, hk = bh & 1;
  const int t0 = qt * 32 + wid * 4;
  float* pg = (float*)smem + wid * (2048 + 128);
  float* impb = pg + 2048;
  const int col = lane & 15, h = lane >> 4, qi = col >> 2, g = col & 3;
  const int t = t0 + qi;
  const u16* proj = (const u16*)(p.ws + OFF_BIG);
  const size_t rowq = (size_t)(b * S_ + t) * PW;
  const bf16x8 q0 = *(const bf16x8*)(proj + rowq + 1024 + (hk * 4 + g) * 64 + 8 * h);
  const bf16x8 q1 = *(const bf16x8*)(proj + rowq + 1024 + (hk * 4 + g) * 64 + 32 + 8 * h);
  const float gt0 = sigm(bf2f(proj[rowq + 2304 + hk * 12 + g * 3 + 0]));
  const float gt1 = sigm(bf2f(proj[rowq + 2304 + hk * 12 + g * 3 + 1]));
  const float gt2 = sigm(bf2f(proj[rowq + 2304 + hk * 12 + g * 3 + 2]));
  f32x4 outa[4];
#pragma unroll
  for (int mt = 0; mt < 4; mt++) outa[mt] = (f32x4){0.f, 0.f, 0.f, 0.f};
  const int tb = t0 >> 6;

  for (int i = lane; i < 2048; i += 64) pg[i] = 0.f;
  const int nmaxw = (t0 + 3 >= 31) ? ((t0 + 3 - 31) >> 4) : -1;
  if (nmaxw >= 0) {
    const u16* kcb = (const u16*)(p.ws + OFF_KC) + (size_t)bh * 512 * 64;
    const u16* vcb = (const u16*)(p.ws + OFF_VCT) + (size_t)bh * 64 * 512;
    const int nblk = (nmaxw >> 6) + 1;
    const int nqv = (t >= 31) ? ((t - 31) >> 4) : -1;
    float m_run = NEGF, l_run = 0.f;
    for (int blk = 0; blk < nblk; blk++) {
      f32x4 st[4];
      qk_block(kcb + (size_t)blk * 64 * 64, 64, q0, q1, st, lane);
      float bm = NEGF;
#pragma unroll
      for (int i = 0; i < 4; i++)
#pragma unroll
        for (int r = 0; r < 4; r++) {
          const int n = blk * 64 + 32 * (i >> 1) + 8 * h + 4 * (i & 1) + r;
          const float v = (n <= nqv) ? st[i][r] : NEGF;
          st[i][r] = v; bm = fmaxf(bm, v);
        }
      bm = fmaxf(bm, __shfl_xor(bm, 16)); bm = fmaxf(bm, __shfl_xor(bm, 32));
      const float mn = fmaxf(m_run, bm);
      float ps = 0.f;
#pragma unroll
      for (int i = 0; i < 4; i++)
#pragma unroll
        for (int r = 0; r < 4; r++) ps += (st[i][r] > -1e29f) ? __expf(st[i][r] - mn) : 0.f;
      l_run = l_run * __expf(m_run - mn) + ps; m_run = mn;
    }
    float lt = l_run; lt += __shfl_xor(lt, 16); lt += __shfl_xor(lt, 32);
    const float inv = lt > 0.f ? 1.f / lt : 0.f;
    f32x4 o[4];
#pragma unroll
    for (int mt = 0; mt < 4; mt++) o[mt] = (f32x4){0.f, 0.f, 0.f, 0.f};
    for (int blk = 0; blk < nblk; blk++) {
      f32x4 st[4];
      qk_block(kcb + (size_t)blk * 64 * 64, 64, q0, q1, st, lane);
#pragma unroll
      for (int i = 0; i < 4; i++)
#pragma unroll
        for (int r = 0; r < 4; r++) {
          const int n = blk * 64 + 32 * (i >> 1) + 8 * h + 4 * (i & 1) + r;
          const float pv = (n <= nqv) ? __expf(st[i][r] - m_run) * inv : 0.f;
          st[i][r] = pv;
          float psum = pv; psum += __shfl_xor(psum, 1); psum += __shfl_xor(psum, 2);
          if (g == 0) pg[qi * 512 + n] = psum;
        }
      pv_block(vcb + blk * 64, 512, packp(st[0], st[1]), packp(st[2], st[3]), o, lane);
    }
#pragma unroll
    for (int mt = 0; mt < 4; mt++) { outa[mt][0] += gt0 * o[mt][0]; outa[mt][1] += gt0 * o[mt][1]; outa[mt][2] += gt0 * o[mt][2]; outa[mt][3] += gt0 * o[mt][3]; }
  }
  __builtin_amdgcn_fence(__ATOMIC_RELEASE, "wavefront");
  asm volatile("s_waitcnt lgkmcnt(0)" ::: "memory");

  unsigned long long mylo = 0, myhi = 0, ulo = 0, uhi = 0;
  if (tb <= 15) { mylo = (2ull << tb) - 1ull; ulo = mylo; }
  else {
    for (int qq = 0; qq < 4; qq++) {
      const float* pgq = pg + qq * 512;
      const int j0 = lane, j1 = lane + 64;
      const bool c0ok = (j0 >= 1 && j0 <= tb - 2), c1ok = (j1 <= tb - 2);
      float v0 = -1.f, v1 = -1.f;
      if (c0ok) v0 = pgq[4 * j0 - 1] + pgq[4 * j0] + pgq[4 * j0 + 1] + pgq[4 * j0 + 2] + pgq[4 * j0 + 3];
      if (c1ok) v1 = pgq[4 * j1 - 1] + pgq[4 * j1] + pgq[4 * j1 + 1] + pgq[4 * j1 + 2] + pgq[4 * j1 + 3];
      asm volatile("s_waitcnt lgkmcnt(0)" ::: "memory");
      impb[j0] = v0; impb[j1] = v1;
      asm volatile("s_waitcnt lgkmcnt(0)" ::: "memory");
      int c0 = 0, c1 = 0;
      for (int jj = 1; jj <= tb - 2; jj++) {
        const float vv = impb[jj];
        c0 += ((vv > v0) || (vv == v0 && jj < j0)) ? 1 : 0;
        c1 += ((vv > v1) || (vv == v1 && jj < j1)) ? 1 : 0;
      }
      const bool s0 = (c0ok && c0 < 13) || j0 == 0 || j0 == tb || j0 == tb - 1;
      const bool s1 = (c1ok && c1 < 13) || j1 == tb || j1 == tb - 1;
      const unsigned long long blo = __ballot(s0), bhi_ = __ballot(s1);
      if (qi == qq) { mylo = blo; myhi = bhi_; }
      ulo |= blo; uhi |= bhi_;
      asm volatile("s_waitcnt lgkmcnt(0)" ::: "memory");
    }
  }

  {
    const u16* ksb = proj + (size_t)b * S_ * PW + 1792 + hk * 64;
    const u16* vsb = (const u16*)(p.ws + OFF_VTS) + (size_t)bh * 64 * S_;
    float m_run = NEGF, l_run = 0.f;
    f32x4 o[4];
#pragma unroll
    for (int mt = 0; mt < 4; mt++) o[mt] = (f32x4){0.f, 0.f, 0.f, 0.f};
    for (int half = 0; half < 2; half++) {
      unsigned long long um = rfl64(half ? uhi : ulo);
      const unsigned long long mym = half ? myhi : mylo;
      while (um) {
        const int bl = __builtin_ctzll(um); um &= um - 1ull;
        const int blk = bl + half * 64;
        const bool selq = (mym >> bl) & 1ull;
        const int kbase = blk * 64;
        attn_block(ksb + (size_t)kbase * PW, PW, vsb + kbase, S_, q0, q1, m_run, l_run, o,
                   [&](int kk) { return selq && (kbase + kk <= t); }, lane);
      }
    }
    float lt = l_run; lt += __shfl_xor(lt, 16); lt += __shfl_xor(lt, 32);
    const float w = lt > 0.f ? gt1 / lt : 0.f;
#pragma unroll
    for (int mt = 0; mt < 4; mt++) { outa[mt][0] += w * o[mt][0]; outa[mt][1] += w * o[mt][1]; outa[mt][2] += w * o[mt][2]; outa[mt][3] += w * o[mt][3]; }
  }
  {
    const u16* kwb = proj + (size_t)b * S_ * PW + 2048 + hk * 64;
    const u16* vwb = (const u16*)(p.ws + OFF_VTW) + (size_t)bh * 64 * S_;
    float m_run = NEGF, l_run = 0.f;
    f32x4 o[4];
#pragma unroll
    for (int mt = 0; mt < 4; mt++) o[mt] = (f32x4){0.f, 0.f, 0.f, 0.f};
    const int wb0 = (t0 >= 511) ? ((t0 - 511) >> 6) : 0;
    for (int blk = wb0; blk <= tb; blk++) {
      const int kbase = blk * 64;
      attn_block(kwb + (size_t)kbase * PW, PW, vwb + kbase, S_, q0, q1, m_run, l_run, o,
                 [&](int kk) { const int kp = kbase + kk; return (kp <= t) && (kp > t - 512); }, lane);
    }
    float lt = l_run; lt += __shfl_xor(lt, 16); lt += __shfl_xor(lt, 32);
    const float w = lt > 0.f ? gt2 / lt : 0.f;
#pragma unroll
    for (int mt = 0; mt < 4; mt++) { outa[mt][0] += w * o[mt][0]; outa[mt][1] += w * o[mt][1]; outa[mt][2] += w * o[mt][2]; outa[mt][3] += w * o[mt][3]; }
  }
  u16* mo = (u16*)(p.ws + OFF_MIX) + (size_t)(b * S_ + t) * 1024 + 256 + (hk * 4 + g) * 64 + 4 * h;
#pragma unroll
  for (int mt = 0; mt < 4; mt++) {
    uint2 pk; pk.x = pack2(outa[mt][0], outa[mt][1]); pk.y = pack2(outa[mt][2], outa[mt][3]);
    *(uint2*)(mo + 16 * mt) = pk;
  }
  __syncthreads();
}


constexpr int KROW = 80;
constexpr int STG = 64 * KROW;
DI void qk_lds(const u16* Ks, bf16x8 q0, bf16x8 q1, f32x4 (&st)[4], int lane) {
  const u16* kp = Ks + (lane & 15) * KROW + 8 * (lane >> 4);
#pragma unroll
  for (int i = 0; i < 4; i++) {
    const bf16x8 k0 = *(const bf16x8*)(kp + i * 16 * KROW), k1 = *(const bf16x8*)(kp + i * 16 * KROW + 32);
    f32x4 z = {0.f, 0.f, 0.f, 0.f};
    z = mfma16(k0, q0, z);
    st[i] = mfma16(k1, q1, z);
  }
}
DI void pv_lds(const u16* Vs, bf16x8 p0, bf16x8 p1, f32x4 (&o)[4], int lane) {
  const u16* vp = Vs + (lane & 15) * KROW + 8 * (lane >> 4);
#pragma unroll
  for (int mt = 0; mt < 4; mt++) {
    const bf16x8 v0 = *(const bf16x8*)(vp + mt * 16 * KROW), v1 = *(const bf16x8*)(vp + mt * 16 * KROW + 32);
    o[mt] = mfma16(v0, p0, o[mt]);
    o[mt] = mfma16(v1, p1, o[mt]);
  }
}
constexpr float LOG2E = 1.4426950408889634f;
DI float xmax16(float v) { const unsigned u = __float_as_uint(v); auto r = __builtin_amdgcn_permlane16_swap(u, u, false, false); return fmaxf(__uint_as_float(r[0]), __uint_as_float(r[1])); }
DI float xmax32(float v) { const unsigned u = __float_as_uint(v); auto r = __builtin_amdgcn_permlane32_swap(u, u, false, false); return fmaxf(__uint_as_float(r[0]), __uint_as_float(r[1])); }
template <int MODE, class MF>
DI void attn_lds(const u16* Ks, const u16* Vs, bf16x8 q0, bf16x8 q1, float& m_run, float& l_run, f32x4 (&o)[4], MF mask, bool selq, int lane) {
  f32x4 st[4];
  bf16x8 kf[8], vf[8];
  {
    const u16* kp = Ks + (lane & 15) * KROW + 8 * (lane >> 4);
    const u16* vp = Vs + (lane & 15) * KROW + 8 * (lane >> 4);
#pragma unroll
    for (int i = 0; i < 4; i++) { kf[2 * i] = *(const bf16x8*)(kp + i * 16 * KROW); kf[2 * i + 1] = *(const bf16x8*)(kp + i * 16 * KROW + 32); }
#pragma unroll
    for (int i = 0; i < 4; i++) { vf[2 * i] = *(const bf16x8*)(vp + i * 16 * KROW); vf[2 * i + 1] = *(const bf16x8*)(vp + i * 16 * KROW + 32); }
  }
  __builtin_amdgcn_sched_barrier(0);
#pragma unroll
  for (int i = 0; i < 4; i++) {
    f32x4 z = {0.f, 0.f, 0.f, 0.f};
    z = mfma16(kf[2 * i], q0, z);
    st[i] = mfma16(kf[2 * i + 1], q1, z);
  }
  const int h = lane >> 4;
  float bm = NEGF;
#pragma unroll
  for (int i = 0; i < 4; i++)
#pragma unroll
    for (int r = 0; r < 4; r++) {
      if (MODE == 2) {
        const int kk = 32 * (i >> 1) + 8 * h + 4 * (i & 1) + r;
        st[i][r] = mask(kk) ? st[i][r] : NEGF;
      }
      bm = fmaxf(bm, st[i][r]);
    }
  if (MODE == 1) bm = selq ? bm : NEGF;
  bm = xmax32(xmax16(bm));
  const float mn = fmaxf(m_run, bm);
  const float sc = __builtin_amdgcn_exp2f((m_run - mn) * LOG2E);
  float mns = fmaxf(mn, -1e20f) * LOG2E;
  if (MODE == 1) mns = selq ? mns : 1e30f;
  float ps = 0.f;
#pragma unroll
  for (int i = 0; i < 4; i++)
#pragma unroll
    for (int r = 0; r < 4; r++) {
      const float pv = __builtin_amdgcn_exp2f(fmaf(st[i][r], LOG2E, -mns));
      st[i][r] = pv; ps += pv;
    }
  l_run = l_run * sc + ps; m_run = mn;
#pragma unroll
  for (int mt = 0; mt < 4; mt++) { o[mt][0] *= sc; o[mt][1] *= sc; o[mt][2] *= sc; o[mt][3] *= sc; }
  const bf16x8 p0 = packp(st[0], st[1]), p1 = packp(st[2], st[3]);
#pragma unroll
  for (int mt = 0; mt < 4; mt++) {
    o[mt] = mfma16(vf[2 * mt], p0, o[mt]);
    o[mt] = mfma16(vf[2 * mt + 1], p1, o[mt]);
  }
}

DI void nsa_item2(const P& p, int item, char* smem) {
  const int tid = tidx(), lane = tid & 63, wid = tid >> 6;
  const int bh = item & 7, qt = 255 - (item >> 3);
  const int b = bh >> 1, hk = bh & 1;
  const int t0 = qt * 32 + wid * 4;
  u16* stg = (u16*)smem;
  float* impw = (float*)(smem + 2 * 2 * 2 * STG * 2) + wid * 1024;
  const int col = lane & 15, h = lane >> 4, qi = col >> 2, g = col & 3;
  const int t = t0 + qi;
  const u16* proj = (const u16*)(p.ws + OFF_BIG);
  const size_t rowq = (size_t)(b * S_ + t) * PW;
  const bf16x8 q0 = *(const bf16x8*)(proj + rowq + 1024 + (hk * 4 + g) * 64 + 8 * h);
  const bf16x8 q1 = *(const bf16x8*)(proj + rowq + 1024 + (hk * 4 + g) * 64 + 32 + 8 * h);
  const float gt0 = sigm(bf2f(proj[rowq + 2304 + hk * 12 + g * 3 + 0]));
  const float gt1 = sigm(bf2f(proj[rowq + 2304 + hk * 12 + g * 3 + 1]));
  const float gt2 = sigm(bf2f(proj[rowq + 2304 + hk * 12 + g * 3 + 2]));
  f32x4 outa[4], o[4];
#pragma unroll
  for (int mt = 0; mt < 4; mt++) { outa[mt] = (f32x4){0.f, 0.f, 0.f, 0.f}; o[mt] = (f32x4){0.f, 0.f, 0.f, 0.f}; }
  const int tb = qt >> 1;
  const int nc = (qt >> 5) + 1;
  const int wb0 = (qt * 32 >= 511) ? ((qt * 32 - 511) >> 6) : 0;
  const int nw = tb - wb0 + 1;
  const int U = 2 * nc + nw + tb + 1;
  const int nqv = (t >= 31) ? ((t - 31) >> 4) : -1;
  const u16* kcb = (const u16*)(p.ws + OFF_KC) + (size_t)bh * 512 * 64;
  const u16* vcb = (const u16*)(p.ws + OFF_VCT) + (size_t)bh * 64 * 512;
  const u16* ksb = proj + (size_t)b * S_ * PW + 1792 + hk * 64;
  const u16* vsb = (const u16*)(p.ws + OFF_VTS) + (size_t)bh * 64 * S_;
  const u16* kwb = proj + (size_t)b * S_ * PW + 2048 + hk * 64;
  const u16* vwb = (const u16*)(p.ws + OFF_VTW) + (size_t)bh * 64 * S_;
  const int srow = tid >> 3, sch = (tid & 7) * 8;
  const int klr = 16 * (2 * (srow >> 5) + ((srow >> 2) & 1)) + 4 * ((srow >> 3) & 3) + (srow & 3);
  const int koff = klr * KROW + sch, voff = srow * KROW + sch;
  uint4 rk0 = make_uint4(0,0,0,0), rk1 = rk0, rv0 = rk0, rv1 = rk0;
#define LDBLK(u_, rk_, rv_) do { const int uu_ = (u_); const u16 *kp_, *vp_; \
    if (uu_ < 2 * nc) { const int bl_ = (uu_ < nc) ? uu_ : uu_ - nc; kp_ = kcb + (size_t)(bl_ * 64 + srow) * 64 + sch; vp_ = vcb + (size_t)srow * 512 + bl_ * 64 + sch; } \
    else if (uu_ < 2 * nc + nw) { const int bl_ = wb0 + (uu_ - 2 * nc); kp_ = kwb + (size_t)(bl_ * 64 + srow) * PW + sch; vp_ = vwb + (size_t)srow * S_ + bl_ * 64 + sch; } \
    else { const int bl_ = uu_ - 2 * nc - nw; kp_ = ksb + (size_t)(bl_ * 64 + srow) * PW + sch; vp_ = vsb + (size_t)srow * S_ + bl_ * 64 + sch; } \
    rk_ = *(const uint4*)kp_; rv_ = *(const uint4*)vp_; } while (0)
  const int nst = (U + 1) >> 1;
  LDBLK(0, rk0, rv0);
  if (1 < U) LDBLK(1, rk1, rv1);
  *(uint4*)(stg + koff) = rk0; *(uint4*)(stg + STG + voff) = rv0;
  *(uint4*)(stg + 2 * STG + koff) = rk1; *(uint4*)(stg + 3 * STG + voff) = rv1;
  __syncthreads();
  float m_run = NEGF, l_run = 0.f, inv = 0.f;
  unsigned long long mylo = 0, myhi = 0, ulo = 0, uhi = 0;
  for (int s = 0; s < nst; s++) {
    if (s + 1 < nst) {
      LDBLK(2 * s + 2, rk0, rv0);
      if (2 * s + 3 < U) LDBLK(2 * s + 3, rk1, rv1);
    }
    const u16* sb = stg + (s & 1) * 4 * STG;
#pragma unroll
    for (int half = 0; half < 2; half++) {
      const int u = 2 * s + half;
      if (u >= U) break;
      const u16* Ks = sb + half * 2 * STG;
      const u16* Vs = Ks + STG;
      if (u < nc) {
        f32x4 st[4];
        qk_lds(Ks, q0, q1, st, lane);
        float bm = NEGF;
#pragma unroll
        for (int i = 0; i < 4; i++)
#pragma unroll
          for (int r = 0; r < 4; r++) {
            const int n = u * 64 + 32 * (i >> 1) + 8 * h + 4 * (i & 1) + r;
            const float v = (n <= nqv) ? st[i][r] : NEGF;
            st[i][r] = v; bm = fmaxf(bm, v);
          }
        bm = fmaxf(bm, __shfl_xor(bm, 16)); bm = fmaxf(bm, __shfl_xor(bm, 32));
        const float mn = fmaxf(m_run, bm);
        float ps = 0.f;
#pragma unroll
        for (int i = 0; i < 4; i++)
#pragma unroll
          for (int r = 0; r < 4; r++) ps += (st[i][r] > -1e29f) ? __expf(st[i][r] - mn) : 0.f;
        l_run = l_run * __expf(m_run - mn) + ps; m_run = mn;
        if (u == nc - 1) {
          float lt = l_run; lt += __shfl_xor(lt, 16); lt += __shfl_xor(lt, 32);
          inv = lt > 0.f ? 1.f / lt : 0.f;
        }
      } else if (u < 2 * nc) {
        const int blk = u - nc;
        f32x4 st[4];
        qk_lds(Ks, q0, q1, st, lane);
#pragma unroll
        for (int i = 0; i < 4; i++) {
          float a4 = 0.f, b3 = 0.f;
#pragma unroll
          for (int r = 0; r < 4; r++) {
            const int n = blk * 64 + 32 * (i >> 1) + 8 * h + 4 * (i & 1) + r;
            const float pv = (n <= nqv) ? __expf(st[i][r] - m_run) * inv : 0.f;
            st[i][r] = pv; a4 += pv; if (r == 3) b3 = pv;
          }
          a4 += __shfl_xor(a4, 1); a4 += __shfl_xor(a4, 2);
          b3 += __shfl_xor(b3, 1); b3 += __shfl_xor(b3, 2);
          if (g == 0) {
            const int j = blk * 16 + 8 * (i >> 1) + 2 * h + (i & 1);
            *(float2*)(impw + (qi * 128 + j) * 2) = make_float2(a4, b3);
          }
        }
        pv_lds(Vs, packp(st[0], st[1]), packp(st[2], st[3]), o, lane);
        if (u == 2 * nc - 1) {
#pragma unroll
          for (int mt = 0; mt < 4; mt++) {
            outa[mt][0] += gt0 * o[mt][0]; outa[mt][1] += gt0 * o[mt][1]; outa[mt][2] += gt0 * o[mt][2]; outa[mt][3] += gt0 * o[mt][3];
            o[mt] = (f32x4){0.f, 0.f, 0.f, 0.f};
          }
          m_run = NEGF; l_run = 0.f;
          asm volatile("s_waitcnt lgkmcnt(0)" ::: "memory");
          if (tb <= 15) { mylo = (2ull << tb) - 1ull; ulo = mylo; }
          else {
            for (int qq = 0; qq < 4; qq++) {
              const float* iw = impw + qq * 256;
              const int j0 = lane, j1 = lane + 64;
              const bool c0ok = (j0 >= 1 && j0 <= tb - 2), c1ok = (j1 <= tb - 2);
              unsigned k0 = 0, k1 = 0;
              if (c0ok) k0 = __float_as_uint(iw[2 * j0] + iw[2 * j0 - 1]) + 1u;
              if (c1ok) k1 = __float_as_uint(iw[2 * j1] + iw[2 * j1 - 1]) + 1u;
              unsigned thr = 0;
              for (int bit = 30; bit >= 0; bit--) {
                const unsigned trial = thr | (1u << bit);
                const int cnt = __popcll(__ballot(k0 >= trial)) + __popcll(__ballot(k1 >= trial));
                if (cnt >= 13) thr = trial;
              }
              const unsigned long long glo = __ballot(k0 > thr), ghi = __ballot(k1 > thr);
              const unsigned long long elo = __ballot(k0 == thr), ehi = __ballot(k1 == thr);
              const int need = 13 - __popcll(glo) - __popcll(ghi);
              const unsigned long long ltm = (1ull << lane) - 1ull;
              const int pre0 = __popcll(elo & ltm), pre1 = __popcll(elo) + __popcll(ehi & ltm);
              const bool s0 = (k0 > thr) || (k0 == thr && pre0 < need) || j0 == 0 || j0 == tb || j0 == tb - 1;
              const bool s1 = (k1 > thr) || (k1 == thr && pre1 < need) || j1 == tb || j1 == tb - 1;
              const unsigned long long blo = __ballot(s0), bhi_ = __ballot(s1);
              if (qi == qq) { mylo = blo; myhi = bhi_; }
              ulo |= blo; uhi |= bhi_;
            }
          }
        }
      } else if (u < 2 * nc + nw) {
        const int kbase = (wb0 + (u - 2 * nc)) * 64;
        if (kbase + 63 <= t0 && kbase > t0 + 3 - 512) attn_lds<0>(Ks, Vs, q0, q1, m_run, l_run, o, [&](int kk) { return true; }, true, lane);
        else attn_lds<2>(Ks, Vs, q0, q1, m_run, l_run, o, [&](int kk) { const int kp = kbase + kk; return (kp <= t) && (kp > t - 512); }, true, lane);
        if (u == 2 * nc + nw - 1) {
          float lt = l_run; lt += __shfl_xor(lt, 16); lt += __shfl_xor(lt, 32);
          const float w = lt > 0.f ? gt2 / lt : 0.f;
#pragma unroll
          for (int mt = 0; mt < 4; mt++) {
            outa[mt][0] += w * o[mt][0]; outa[mt][1] += w * o[mt][1]; outa[mt][2] += w * o[mt][2]; outa[mt][3] += w * o[mt][3];
            o[mt] = (f32x4){0.f, 0.f, 0.f, 0.f};
          }
          m_run = NEGF; l_run = 0.f;
        }
      } else {
        const int blk = u - 2 * nc - nw;
        const unsigned long long um = rfl64(blk < 64 ? ulo : uhi);
        if ((um >> (blk & 63)) & 1ull) {
          const bool selq = ((blk < 64 ? mylo : myhi) >> (blk & 63)) & 1ull;
          const int kbase = blk * 64;
          if (blk < tb) attn_lds<1>(Ks, Vs, q0, q1, m_run, l_run, o, [&](int kk) { return true; }, selq, lane);
          else attn_lds<2>(Ks, Vs, q0, q1, m_run, l_run, o, [&](int kk) { return selq && (kbase + kk <= t); }, selq, lane);
        }
      }
    }
    if (s + 1 < nst) {
      u16* db = stg + ((s + 1) & 1) * 4 * STG;
      *(uint4*)(db + koff) = rk0; *(uint4*)(db + STG + voff) = rv0;
      *(uint4*)(db + 2 * STG + koff) = rk1; *(uint4*)(db + 3 * STG + voff) = rv1;
    }
    __syncthreads();
  }
#undef LDBLK
  {
    float lt = l_run; lt += __shfl_xor(lt, 16); lt += __shfl_xor(lt, 32);
    const float w = lt > 0.f ? gt1 / lt : 0.f;
#pragma unroll
    for (int mt = 0; mt < 4; mt++) { outa[mt][0] += w * o[mt][0]; outa[mt][1] += w * o[mt][1]; outa[mt][2] += w * o[mt][2]; outa[mt][3] += w * o[mt][3]; }
  }
  u16* mo = (u16*)(p.ws + OFF_MIX) + (size_t)(b * S_ + t) * 1024 + 256 + (hk * 4 + g) * 64 + 4 * h;
#pragma unroll
  for (int mt = 0; mt < 4; mt++) {
    uint2 pk; pk.x = pack2(outa[mt][0], outa[mt][1]); pk.y = pack2(outa[mt][2], outa[mt][3]);
    *(uint2*)(mo + 16 * mt) = pk;
  }
}


DI void load_frags(const u16* Ks, const u16* Vs, bf16x8 (&kf)[8], bf16x8 (&vf)[8], int lane) {
  const u16* kp = Ks + (lane & 15) * KROW + 8 * (lane >> 4);
  const u16* vp = Vs + (lane & 15) * KROW + 8 * (lane >> 4);
#pragma unroll
  for (int i = 0; i < 4; i++) { kf[2 * i] = *(const bf16x8*)(kp + i * 16 * KROW); kf[2 * i + 1] = *(const bf16x8*)(kp + i * 16 * KROW + 32); }
#pragma unroll
  for (int i = 0; i < 4; i++) { vf[2 * i] = *(const bf16x8*)(vp + i * 16 * KROW); vf[2 * i + 1] = *(const bf16x8*)(vp + i * 16 * KROW + 32); }
}
template <int MODE, class MF>
DI void attn_core(const bf16x8 (&kf)[8], const bf16x8 (&vf)[8], bf16x8 q0, bf16x8 q1, float& m_run, float& l_run, f32x4 (&o)[4], MF mask, bool selq, int lane) {
  f32x4 st[4];
#pragma unroll
  for (int i = 0; i < 4; i++) {
    f32x4 z = {0.f, 0.f, 0.f, 0.f};
    z = mfma16(kf[2 * i], q0, z);
    st[i] = mfma16(kf[2 * i + 1], q1, z);
  }
  const int h = lane >> 4;
  float bm = NEGF;
#pragma unroll
  for (int i = 0; i < 4; i++)
#pragma unroll
    for (int r = 0; r < 4; r++) {
      if (MODE == 2) {
        const int kk = 32 * (i >> 1) + 8 * h + 4 * (i & 1) + r;
        st[i][r] = mask(kk) ? st[i][r] : NEGF;
      }
      bm = fmaxf(bm, st[i][r]);
    }
  if (MODE == 1) bm = selq ? bm : NEGF;
  bm = xmax32(xmax16(bm));
  const float mn = fmaxf(m_run, bm);
  const float sc = __builtin_amdgcn_exp2f((m_run - mn) * LOG2E);
  float mns = fmaxf(mn, -1e20f) * LOG2E;
  if (MODE == 1) mns = selq ? mns : 1e30f;
  float ps = 0.f;
#pragma unroll
  for (int i = 0; i < 4; i++)
#pragma unroll
    for (int r = 0; r < 4; r++) {
      const float pv = __builtin_amdgcn_exp2f(fmaf(st[i][r], LOG2E, -mns));
      st[i][r] = pv; ps += pv;
    }
  l_run = l_run * sc + ps; m_run = mn;
#pragma unroll
  for (int mt = 0; mt < 4; mt++) { o[mt][0] *= sc; o[mt][1] *= sc; o[mt][2] *= sc; o[mt][3] *= sc; }
  const bf16x8 p0 = packp(st[0], st[1]), p1 = packp(st[2], st[3]);
#pragma unroll
  for (int mt = 0; mt < 4; mt++) {
    o[mt] = mfma16(vf[2 * mt], p0, o[mt]);
    o[mt] = mfma16(vf[2 * mt + 1], p1, o[mt]);
  }
}


DI void load_k(const u16* Ks, bf16x8 (&kf)[8], int lane) {
  const u16* kp = Ks + (lane & 15) * KROW + 8 * (lane >> 4);
#pragma unroll
  for (int i = 0; i < 4; i++) { kf[2 * i] = *(const bf16x8*)(kp + i * 16 * KROW); kf[2 * i + 1] = *(const bf16x8*)(kp + i * 16 * KROW + 32); }
}
template <class MF>
DI void qk_part(const bf16x8 (&kf)[8], bf16x8 q0, bf16x8 q1, f32x4 (&st)[4], bool domask, MF mask, int lane) {
#pragma unroll
  for (int i = 0; i < 4; i++) {
    f32x4 z = {0.f, 0.f, 0.f, 0.f};
    z = mfma16(kf[2 * i], q0, z);
    st[i] = mfma16(kf[2 * i + 1], q1, z);
  }
  if (domask) {
#pragma unroll
    for (int i = 0; i < 4; i++)
#pragma unroll
      for (int r = 0; r < 4; r++) {
        const int cc = 32 * (i >> 1) + 4 * (i & 1) + r;
        st[i][r] = mask(cc) ? st[i][r] : NEGF;
      }
  }
}
DI void sm_pv_part(f32x4 (&st)[4], const bf16x8 (&vf)[8], float& m_run, float& l_run, f32x4 (&o)[4], bool selq, int lane) {
  float bm = NEGF;
#pragma unroll
  for (int i = 0; i < 4; i++)
#pragma unroll
    for (int r = 0; r < 4; r++) bm = fmaxf(bm, st[i][r]);
  bm = selq ? bm : NEGF;
  bm = xmax32(xmax16(bm));
  if (!__all(bm - m_run <= 8.f)) {
    const float mn = fmaxf(m_run, bm);
    const float sc = __builtin_amdgcn_exp2f((m_run - mn) * LOG2E);
    l_run *= sc; m_run = mn;
#pragma unroll
    for (int mt = 0; mt < 4; mt++) { o[mt][0] *= sc; o[mt][1] *= sc; o[mt][2] *= sc; o[mt][3] *= sc; }
  }
  float mns = fmaxf(m_run, -1e20f) * LOG2E;
  mns = selq ? mns : 1e30f;
  float ps = 0.f;
#pragma unroll
  for (int i = 0; i < 4; i++)
#pragma unroll
    for (int r = 0; r < 4; r++) {
      const float pv = __builtin_amdgcn_exp2f(fmaf(st[i][r], LOG2E, -mns));
      st[i][r] = pv; ps += pv;
    }
  l_run += ps;
  const bf16x8 p0 = packp(st[0], st[1]), p1 = packp(st[2], st[3]);
#pragma unroll
  for (int mt = 0; mt < 4; mt++) {
    o[mt] = mfma16(vf[2 * mt], p0, o[mt]);
    o[mt] = mfma16(vf[2 * mt + 1], p1, o[mt]);
  }
}

constexpr int NSA3_SMEM = 8 * STG * 2 + 8 * 8192;

DI void nsa_item3(const P& p, int item, char* smem) {
  const int tid = tidx(), lane = tid & 63, wid = __builtin_amdgcn_readfirstlane(tid >> 6);
  const int bh = item & 7, qt = 127 - (item >> 3);
  const int b = bh >> 1, hk = bh & 1;
  const int t0w = qt * 64 + wid * 8;
  u16* stg = (u16*)smem;
  float* impw = (float*)(smem + 8 * STG * 2) + wid * 2048;
  const int col = lane & 15, h = lane >> 4, qi = col >> 2, g = col & 3;
  const u16* proj = (const u16*)(p.ws + OFF_BIG);
  const int tqb = t0w + qi;
  bf16x8 q0[2], q1[2];
  float m_run[2], l_run[2], inv[2];
  f32x4 o[2][4];
  unsigned long long mylo[2], myhi[2], ulo[2], uhi[2];
#pragma unroll
  for (int c = 0; c < 2; c++) {
    const size_t rowq = (size_t)(b * S_ + tqb + 4 * c) * PW;
    q0[c] = *(const bf16x8*)(proj + rowq + 1024 + (hk * 4 + g) * 64 + 8 * h);
    q1[c] = *(const bf16x8*)(proj + rowq + 1024 + (hk * 4 + g) * 64 + 32 + 8 * h);
    m_run[c] = NEGF; l_run[c] = 0.f; inv[c] = 0.f;
    mylo[c] = 0; myhi[c] = 0; ulo[c] = 0; uhi[c] = 0;
#pragma unroll
    for (int mt = 0; mt < 4; mt++) o[c][mt] = (f32x4){0.f, 0.f, 0.f, 0.f};
  }
  const int tb = qt;
  const int nc = (qt >> 4) + 1;
  const int wb0 = (qt >= 8) ? (qt - 8) : 0;
  const int nw = tb - wb0 + 1;
  const int U = 2 * nc + nw + tb + 1;
  const u16* kcb = (const u16*)(p.ws + OFF_KC) + (size_t)bh * 512 * 64;
  const u16* vcb = (const u16*)(p.ws + OFF_VCT) + (size_t)bh * 64 * 512;
  const u16* ksb = proj + (size_t)b * S_ * PW + 1792 + hk * 64;
  const u16* vsb = (const u16*)(p.ws + OFF_VTS) + (size_t)bh * 64 * S_;
  const u16* kwb = proj + (size_t)b * S_ * PW + 2048 + hk * 64;
  const u16* vwb = (const u16*)(p.ws + OFF_VTW) + (size_t)bh * 64 * S_;
  const int srow = tid >> 3, sch = (tid & 7) * 8;
  const int klr = 16 * (2 * (srow >> 5) + ((srow >> 2) & 1)) + 4 * ((srow >> 3) & 3) + (srow & 3);
  const int koff = klr * KROW + sch, voff = srow * KROW + sch;
  uint4 rk0 = make_uint4(0, 0, 0, 0), rk1 = rk0, rv0 = rk0, rv1 = rk0;
#define LDBLK(u_, rk_, rv_) do { const int uu_ = (u_); const u16 *kp_, *vp_; int sr_ = srow; asm volatile("" : "+v"(sr_)); \
    if (uu_ < 2 * nc) { const int bl_ = (uu_ < nc) ? uu_ : uu_ - nc; kp_ = kcb + (unsigned)((bl_ * 64 + sr_) * 64 + sch); vp_ = vcb + (unsigned)(sr_ * 512 + bl_ * 64 + sch); } \
    else if (uu_ < 2 * nc + nw) { const int bl_ = wb0 + (uu_ - 2 * nc); kp_ = kwb + (unsigned)((bl_ * 64 + sr_) * PW + sch); vp_ = vwb + (unsigned)(sr_ * S_ + bl_ * 64 + sch); } \
    else { const int bl_ = uu_ - 2 * nc - nw; kp_ = ksb + (unsigned)((bl_ * 64 + sr_) * PW + sch); vp_ = vsb + (unsigned)(sr_ * S_ + bl_ * 64 + sch); } \
    rk_ = *(const uint4*)kp_; rv_ = *(const uint4*)vp_; } while (0)
#define EMIT_GATE(c_, gidx_, lt_) \
    int tql_ = tqb + 4 * (c_); asm volatile("" : "+v"(tql_)); \
    const float gate_ = sigm(bf2f(proj[(size_t)(b * S_ + tql_) * PW + 2304 + hk * 12 + g * 3 + (gidx_)])); \
    const float w_ = (lt_) > 0.f ? gate_ / (lt_) : 0.f; \
    float4* ps_ = (float4*)impw + ((c_) * 4) * 64 + lane;
#define EMIT_LDS(c_, gidx_, lt_, first_) do { EMIT_GATE(c_, gidx_, lt_) \
    _Pragma("unroll") for (int mt = 0; mt < 4; mt++) { \
      float4 a_ = make_float4(w_ * o[c_][mt][0], w_ * o[c_][mt][1], w_ * o[c_][mt][2], w_ * o[c_][mt][3]); \
      if (!(first_)) { const float4 pr_ = ps_[mt * 64]; a_.x += pr_.x; a_.y += pr_.y; a_.z += pr_.z; a_.w += pr_.w; } \
      ps_[mt * 64] = a_; \
      o[c_][mt] = (f32x4){0.f, 0.f, 0.f, 0.f}; } \
    m_run[c_] = NEGF; l_run[c_] = 0.f; } while (0)
#define EMIT_FINAL(c_, gidx_, lt_) do { EMIT_GATE(c_, gidx_, lt_) \
    u16* mo_ = (u16*)(p.ws + OFF_MIX) + (size_t)(b * S_ + tql_) * 1024 + 256 + (hk * 4 + g) * 64 + 4 * h; \
    _Pragma("unroll") for (int mt = 0; mt < 4; mt++) { \
      const float4 pr_ = ps_[mt * 64]; \
      uint2 pk_; pk_.x = pack2(pr_.x + w_ * o[c_][mt][0], pr_.y + w_ * o[c_][mt][1]); pk_.y = pack2(pr_.z + w_ * o[c_][mt][2], pr_.w + w_ * o[c_][mt][3]); \
      *(uint2*)(mo_ + 16 * mt) = pk_; } } while (0)
  const int nst = (U + 1) >> 1;
  LDBLK(0, rk0, rv0);
  if (1 < U) LDBLK(1, rk1, rv1);
  *(uint4*)(stg + koff) = rk0; *(uint4*)(stg + STG + voff) = rv0;
  *(uint4*)(stg + 2 * STG + koff) = rk1; *(uint4*)(stg + 3 * STG + voff) = rv1;
  __syncthreads();
  for (int s = 0; s < nst; s++) {
    if (s + 1 < nst) {
      LDBLK(2 * s + 2, rk0, rv0);
      if (2 * s + 3 < U) LDBLK(2 * s + 3, rk1, rv1);
    }
    const u16* sb = stg + (s & 1) * 4 * STG;
#pragma unroll 1
    for (int half = 0; half < 2; half++) {
      const int u = 2 * s + half;
      if (u >= U) break;
      const u16* Ks = sb + half * 2 * STG;
      const u16* Vs = Ks + STG;
      if (u < nc) {
        bf16x8 kf[8];
        load_k(Ks, kf, lane);
#pragma unroll
        for (int c = 0; c < 2; c++) {
          f32x4 st[4];
          int nlim = ((tqb + 4 * c - 31) >> 4) - u * 64 - 8 * h; asm volatile("" : "+v"(nlim));
          qk_part(kf, q0[c], q1[c], st, true, [&](int cc) { return cc <= nlim; }, lane);
          float bm = NEGF;
#pragma unroll
          for (int i = 0; i < 4; i++)
#pragma unroll
            for (int r = 0; r < 4; r++) bm = fmaxf(bm, st[i][r]);
          bm = xmax32(xmax16(bm));
          const float mn = fmaxf(m_run[c], bm);
          const float mns = fmaxf(mn, -1e20f) * LOG2E;
          float ps = 0.f;
#pragma unroll
          for (int i = 0; i < 4; i++)
#pragma unroll
            for (int r = 0; r < 4; r++) ps += __builtin_amdgcn_exp2f(fmaf(st[i][r], LOG2E, -mns));
          l_run[c] = l_run[c] * __builtin_amdgcn_exp2f((m_run[c] - mn) * LOG2E) + ps; m_run[c] = mn;
          if (u == nc - 1) {
            float lt = l_run[c]; lt += __shfl_xor(lt, 16); lt += __shfl_xor(lt, 32);
            inv[c] = lt > 0.f ? 1.f / lt : 0.f;
          }
        }
      } else if (u < 2 * nc) {
        const int blk = u - nc;
        bf16x8 kf[8];
        load_k(Ks, kf, lane);
        f32x4 st0[4], st1[4];
        { int nlim = ((tqb - 31) >> 4) - blk * 64 - 8 * h; asm volatile("" : "+v"(nlim)); qk_part(kf, q0[0], q1[0], st0, true, [&](int cc) { return cc <= nlim; }, lane); }
        { int nlim = ((tqb + 4 - 31) >> 4) - blk * 64 - 8 * h; asm volatile("" : "+v"(nlim)); qk_part(kf, q0[1], q1[1], st1, true, [&](int cc) { return cc <= nlim; }, lane); }
        bf16x8 vf[8];
        load_k(Vs, vf, lane);
#pragma unroll
        for (int c = 0; c < 2; c++) {
          f32x4 (&st)[4] = c == 0 ? st0 : st1;
          const float mns = fmaxf(m_run[c], -1e20f) * LOG2E;
          const float iv = inv[c];
#pragma unroll
          for (int i = 0; i < 4; i++) {
            float a4 = 0.f, b3 = 0.f;
#pragma unroll
            for (int r = 0; r < 4; r++) {
              const float pv = __builtin_amdgcn_exp2f(fmaf(st[i][r], LOG2E, -mns)) * iv;
              st[i][r] = pv; a4 += pv; if (r == 3) b3 = pv;
            }
            a4 += __shfl_xor(a4, 1); a4 += __shfl_xor(a4, 2);
            b3 += __shfl_xor(b3, 1); b3 += __shfl_xor(b3, 2);
            if (g == 0) {
              const int j = blk * 16 + 8 * (i >> 1) + 2 * h + (i & 1);
              *(float2*)(impw + ((c * 4 + qi) * 128 + j) * 2) = make_float2(a4, b3);
            }
          }
          const bf16x8 p0 = packp(st[0], st[1]), p1 = packp(st[2], st[3]);
#pragma unroll
          for (int mt = 0; mt < 4; mt++) {
            o[c][mt] = mfma16(vf[2 * mt], p0, o[c][mt]);
            o[c][mt] = mfma16(vf[2 * mt + 1], p1, o[c][mt]);
          }
        }
        if (u == 2 * nc - 1) {
          asm volatile("s_waitcnt lgkmcnt(0)" ::: "memory");
          if (tb <= 15) { mylo[0] = mylo[1] = (2ull << tb) - 1ull; ulo[0] = ulo[1] = mylo[0]; }
          else {
            for (int qq = 0; qq < 8; qq++) {
              const float* iw = impw + qq * 256;
              const int j0 = lane, j1 = lane + 64;
              const bool c0ok = (j0 >= 1 && j0 <= tb - 2), c1ok = (j1 <= tb - 2);
              unsigned k0 = 0, k1 = 0;
              if (c0ok) k0 = __float_as_uint(iw[2 * j0] + iw[2 * j0 - 1]) + 1u;
              if (c1ok) k1 = __float_as_uint(iw[2 * j1] + iw[2 * j1 - 1]) + 1u;
              unsigned thr = 0;
              for (int bit = 30; bit >= 0; bit--) {
                const unsigned trial = thr | (1u << bit);
                const int cnt = __popcll(__ballot(k0 >= trial)) + __popcll(__ballot(k1 >= trial));
                if (cnt >= 13) thr = trial;
              }
              const unsigned long long glo = __ballot(k0 > thr), ghi = __ballot(k1 > thr);
              const unsigned long long elo = __ballot(k0 == thr), ehi = __ballot(k1 == thr);
              const int need = 13 - __popcll(glo) - __popcll(ghi);
              int ln_ = lane; asm volatile("" : "+v"(ln_));
              const unsigned long long ltm = (1ull << ln_) - 1ull;
              const int pre0 = __popcll(elo & ltm), pre1 = __popcll(elo) + __popcll(ehi & ltm);
              const bool s0 = (k0 > thr) || (k0 == thr && pre0 < need) || j0 == 0 || j0 == tb || j0 == tb - 1;
              const bool s1 = (k1 > thr) || (k1 == thr && pre1 < need) || j1 == tb || j1 == tb - 1;
              const unsigned long long blo = __ballot(s0), bhi_ = __ballot(s1);
#pragma unroll
              for (int c = 0; c < 2; c++) {
                if ((qq >> 2) == c) {
                  if (qi == (qq & 3)) { mylo[c] = blo; myhi[c] = bhi_; }
                  ulo[c] |= blo; uhi[c] |= bhi_;
                }
              }
            }
          }
                  asm volatile("s_waitcnt lgkmcnt(0)" ::: "memory");
#pragma unroll
          for (int c = 0; c < 2; c++) EMIT_LDS(c, 0, 1.f, true);
        }
      } else if (u < 2 * nc + nw) {
        const int kbase = (wb0 + (u - 2 * nc)) * 64;
        bf16x8 kf[8];
        load_k(Ks, kf, lane);
        f32x4 st0[4], st1[4];
        {
          const int t0c = t0w; int lim = tqb - kbase - 8 * h; asm volatile("" : "+v"(lim));
          qk_part(kf, q0[0], q1[0], st0, !(kbase + 63 <= t0c && kbase > t0c + 3 - 512), [&](int cc) { return (cc <= lim) && (cc > lim - 512); }, lane);
        }
        {
          const int t0c = t0w + 4; int lim = tqb + 4 - kbase - 8 * h; asm volatile("" : "+v"(lim));
          qk_part(kf, q0[1], q1[1], st1, !(kbase + 63 <= t0c && kbase > t0c + 3 - 512), [&](int cc) { return (cc <= lim) && (cc > lim - 512); }, lane);
        }
        bf16x8 vf[8];
        load_k(Vs, vf, lane);
        sm_pv_part(st0, vf, m_run[0], l_run[0], o[0], true, lane);
        sm_pv_part(st1, vf, m_run[1], l_run[1], o[1], true, lane);
        if (u == 2 * nc + nw - 1) {
#pragma unroll
          for (int c = 0; c < 2; c++) {
            float lt = l_run[c]; lt += __shfl_xor(lt, 16); lt += __shfl_xor(lt, 32);
            EMIT_LDS(c, 2, lt, false);
          }
        }
      } else {
        const int blk = u - 2 * nc - nw;
        const unsigned long long um0 = rfl64(blk < 64 ? ulo[0] : uhi[0]), um1 = rfl64(blk < 64 ? ulo[1] : uhi[1]);
        const bool need0 = (um0 >> (blk & 63)) & 1ull, need1 = (um1 >> (blk & 63)) & 1ull;
        const int kbase = blk * 64;
        const bool domask = blk >= tb;
        if (need0 && need1) {
          const bool sel0 = ((blk < 64 ? mylo[0] : myhi[0]) >> (blk & 63)) & 1ull;
          const bool sel1 = ((blk < 64 ? mylo[1] : myhi[1]) >> (blk & 63)) & 1ull;
          bf16x8 kf[8];
          load_k(Ks, kf, lane);
          f32x4 st0[4], st1[4];
          { int lim = tqb - kbase - 8 * h; asm volatile("" : "+v"(lim)); qk_part(kf, q0[0], q1[0], st0, domask, [&](int cc) { return cc <= lim; }, lane); }
          { int lim = tqb + 4 - kbase - 8 * h; asm volatile("" : "+v"(lim)); qk_part(kf, q0[1], q1[1], st1, domask, [&](int cc) { return cc <= lim; }, lane); }
          bf16x8 vf[8];
          load_k(Vs, vf, lane);
          sm_pv_part(st0, vf, m_run[0], l_run[0], o[0], sel0, lane);
          sm_pv_part(st1, vf, m_run[1], l_run[1], o[1], sel1, lane);
        } else if (need0) {
          const bool sel0 = ((blk < 64 ? mylo[0] : myhi[0]) >> (blk & 63)) & 1ull;
          bf16x8 kf[8];
          load_k(Ks, kf, lane);
          f32x4 st0[4];
          { int lim = tqb - kbase - 8 * h; asm volatile("" : "+v"(lim)); qk_part(kf, q0[0], q1[0], st0, domask, [&](int cc) { return cc <= lim; }, lane); }
          bf16x8 vf[8];
          load_k(Vs, vf, lane);
          sm_pv_part(st0, vf, m_run[0], l_run[0], o[0], sel0, lane);
        } else if (need1) {
          const bool sel1 = ((blk < 64 ? mylo[1] : myhi[1]) >> (blk & 63)) & 1ull;
          bf16x8 kf[8];
          load_k(Ks, kf, lane);
          f32x4 st1[4];
          { int lim = tqb + 4 - kbase - 8 * h; asm volatile("" : "+v"(lim)); qk_part(kf, q0[1], q1[1], st1, domask, [&](int cc) { return cc <= lim; }, lane); }
          bf16x8 vf[8];
          load_k(Vs, vf, lane);
          sm_pv_part(st1, vf, m_run[1], l_run[1], o[1], sel1, lane);
        }
      }
    }
    if (s + 1 < nst) {
      u16* db = stg + ((s + 1) & 1) * 4 * STG;
      *(uint4*)(db + koff) = rk0; *(uint4*)(db + STG + voff) = rv0;
      *(uint4*)(db + 2 * STG + koff) = rk1; *(uint4*)(db + 3 * STG + voff) = rv1;
    }
    __syncthreads();
  }
#undef LDBLK
#pragma unroll
  for (int c = 0; c < 2; c++) {
    float lt = l_run[c]; lt += __shfl_xor(lt, 16); lt += __shfl_xor(lt, 32);
    EMIT_FINAL(c, 1, lt);
  }
#undef EMIT_GATE
#undef EMIT_LDS
#undef EMIT_FINAL
}

constexpr int N_PHASES = 2 + 9 * 4;

DI void run_phase(const P& p, int ph, char* smem, int* sh_next) {
  const int nb = gridDim.x, bid = blockIdx.x;
  u16* Hb = (u16*)(p.ws + OFF_H);
  u16* proj = (u16*)(p.ws + OFF_BIG);
  u16* mix = (u16*)(p.ws + OFF_MIX);
  if (ph == 0) {
    for (int it = bid; it < PREP_ITEMS; it += 2 * nb) {
      const int itb = it + nb;
      if (itb < PREP_TR) { const TJob ja = decode_tr(p, it), jb = decode_tr(p, itb); transpose_pair(ja, jb, smem); }
      else { prep_item(p, it, smem); if (itb < PREP_ITEMS) prep_item(p, itb, smem); }
    }
    return;
  }
  if (ph == 1) { for (int it = bid; it < T_ / 8; it += nb) ln_rows(p, 0, 0, it); return; }
  const int l = (ph - 2) / 9, k = (ph - 2) % 9;
  switch (k) {
    case 0: {
      Epi256InProj ef{proj, (u16*)(p.ws + OFF_VTS), (u16*)(p.ws + OFF_VTW), (const float*)(p.ws + OFF_COS), (const float*)(p.ws + OFF_SIN)};
      const u16* W = (const u16*)(p.ws + OFF_WIN) + (size_t)l * NPI * 1024;
      for (int it = bid; it < 12 * 128; it += nb) { int pm, pn; g_tile_map(it, 12, 128, pm, pn); gemm256_tile<true>(W, Hb, 1024, pm * 256, pn * 256, ef, smem); }
    } break;
    case 1: {
      unsigned* qc = (unsigned*)(p.ws + OFF_BAR + 14336) + l * 2;
      int it = bid;
      for (;;) {
        if (it >= 64 + 1024 + 2048) break;
        unsigned nx = 0;
        if (threadIdx.x == 0) nx = nb + __hip_atomic_fetch_add(qc, 1u, __ATOMIC_RELAXED, __HIP_MEMORY_SCOPE_AGENT);
        if (it < 64) {
          const int kv = it >> 5, r = it & 31;
          ACmp af{proj, kv ? 1664 : 1536};
          EpiPlain ef{(u16*)(p.ws + OFF_CH) + (size_t)kv * 4096 * 256, 256, 2, (const float*)(p.ws + OFF_CB) + (l * 2 + kv) * 256};
          gemm_tile(af, (const u16*)(p.ws + OFF_CW1) + (size_t)(l * 2 + kv) * 256 * 2048, 2048, (r >> 1) * 256, (r & 1) * 128, ef, smem);
        } else if (it < 64 + 1024) gmlp_item(p, l, it - 64, smem);
        else hgrn_item(p, l, it - 64 - 1024, 0, smem);
        if (threadIdx.x == 0) *sh_next = (int)nx;
        __syncthreads();
        it = *sh_next;
        __syncthreads();
      }
    } break;
    case 2: {
      for (int it = bid; it < 32 + 256; it += nb) {
        if (it < 32) {
          const int kv = it >> 4, r = it & 15;
          APlain af{(const u16*)(p.ws + OFF_CH) + (size_t)kv * 4096 * 256, 256};
          EpiCmp2 ef{(u16*)(p.ws + OFF_KC), (u16*)(p.ws + OFF_VCT), kv};
          gemm_tile(af, (const u16*)(p.ws + OFF_CW2) + (size_t)(l * 2 + kv) * 128 * 256, 256, r * 256, 0, ef, smem);
        } else scan_item(p, it - 32);
      }
    } break;
    case 3: {
      unsigned* qc = (unsigned*)(p.ws + OFF_BAR + 14336) + l * 2 + 1;
      int it = bid;
      for (;;) {
        if (it >= 1024 + 2048) break;
        unsigned nx = 0;
        if (threadIdx.x == 0) nx = nb + __hip_atomic_fetch_add(qc, 1u, __ATOMIC_RELAXED, __HIP_MEMORY_SCOPE_AGENT);
        if (it < 1024) nsa_item3(p, it, smem);
        else hgrn_item(p, l, it - 1024, 1, smem);
        if (threadIdx.x == 0) *sh_next = (int)nx;
        __syncthreads();
        it = *sh_next;
        __syncthreads();
      }
    } break;
    case 4: {
      Epi256Plain ef{(u16*)p.out, 1024, 0};
      const u16* W = (const u16*)(p.ws + OFF_WO) + (size_t)l * 1024 * 1024;
      for (int it = bid; it < 4 * 128; it += nb) { int pm, pn; g_tile_map(it, 4, 128, pm, pn); gemm256_tile<false>(W, mix, 1024, pm * 256, pn * 256, ef, smem); }
    } break;
    case 5: { for (int it = bid; it < T_ / 32; it += nb) ln_rows(p, l, 1, it); } break;
    case 6: {
      Epi256Plain ef{proj, 4096, 1};
      const u16* W = (const u16*)(p.ws + OFF_FF1) + (size_t)l * 4096 * 1024;
      for (int it = bid; it < 16 * 128; it += nb) { int pm, pn; g_tile_map(it, 16, 128, pm, pn); gemm256_tile<true>(W, Hb, 1024, pm * 256, pn * 256, ef, smem); }
    } break;
    case 7: {
      Epi256Plain ef{l == 3 ? (u16*)(p.ws + OFF_YL) : (u16*)p.out, 1024, 0};
      const u16* W = (const u16*)(p.ws + OFF_FF2) + (size_t)l * 1024 * 4096;
      for (int it = bid; it < 4 * 128; it += nb) { int pm, pn; g_tile_map(it, 4, 128, pm, pn); gemm256_tile<false>(W, proj, 4096, pm * 256, pn * 256, ef, smem); }
    } break;
    case 8: { for (int it = bid; it < T_ / 32; it += nb) ln_rows(p, l, 2, it); } break;
  }
}

#define XB_TMO      128
#define XB_XCNT(j)  (256  + 64 * (j))
#define XB_XSUB(j)  (1280 + 64 * (j))
#define XB_XGEN(j)  (2304 + 64 * (j))
#define XB_TOP      3328
#define XB_TOPGEN   3392
#define XCD_BAR_WORDS 3456
#define XB_SPIN_CAP (1u << 18)
#define LAS __attribute__((address_space(3)))
DI unsigned xb_ld(unsigned* p) { return __hip_atomic_load(p, __ATOMIC_RELAXED, __HIP_MEMORY_SCOPE_AGENT); }
DI unsigned xb_add(unsigned* p, unsigned v) { return __hip_atomic_fetch_add(p, v, __ATOMIC_RELAXED, __HIP_MEMORY_SCOPE_AGENT); }
DI unsigned xb_xcc_id() { return (unsigned)__builtin_amdgcn_s_getreg((3 << 11) | 20) & 0xFu; }
#define XB_SPIN(cond, bar) do { unsigned _sp = 0; while (cond) { __builtin_amdgcn_s_sleep(1); \
    if ((++_sp & 255u) == 0u) { if (xb_ld(&(bar)[XB_TMO])) break; if (_sp > XB_SPIN_CAP) { atomicAdd(&(bar)[XB_TMO], 1u); break; } } } } while (0)
struct XcdBarrier { unsigned* bar; unsigned x; volatile LAS unsigned* st; };
DI XcdBarrier xcd_barrier_post(unsigned* bar, volatile LAS unsigned* st) {
  XcdBarrier b; b.bar = bar; b.x = xb_xcc_id(); b.st = st;
  if (threadIdx.x == 0) (void)xb_add(&bar[XB_XCNT(b.x)], 1u);
  return b;
}
DI void xcd_barrier_complete(unsigned* bar, unsigned x, unsigned& nloc, unsigned& nx) {
  const unsigned G = gridDim.x * gridDim.y * gridDim.z;
  unsigned sum, cnt, mine, sp = 0u;
  for (;;) {
    sum = 0u; cnt = 0u; mine = 0u;
#pragma unroll
    for (unsigned j = 0; j < 16; ++j) { const unsigned c = xb_ld(&bar[XB_XCNT(j)]); sum += c; cnt += (c > 0u) ? 1u : 0u; mine = (j == x) ? c : mine; }
    if (sum == G) break;
    __builtin_amdgcn_s_sleep(1);
    if ((++sp & 255u) == 0u) { if (xb_ld(&bar[XB_TMO])) break; if (sp > XB_SPIN_CAP) { atomicAdd(&bar[XB_TMO], 1u); break; } }
  }
  nloc = mine > 0u ? mine : 1u; nx = cnt > 0u ? cnt : 1u;
}
DI void xcd_barrier(const XcdBarrier& b) {
  asm volatile("s_waitcnt vmcnt(0)" ::: "memory");
  __syncthreads();
  if (threadIdx.x == 0) {
    unsigned* bar = b.bar;
    __builtin_amdgcn_s_waitcnt(0);
    unsigned nloc = b.st[0], nx = b.st[1];
    if (nloc == 0u) { xcd_barrier_complete(bar, b.x, nloc, nx); b.st[0] = nloc; b.st[1] = nx; }
    const unsigned old = xb_add(&bar[XB_XSUB(b.x)], 1u);
    const unsigned gen = old / nloc;
    if (old + 1u == (gen + 1u) * nloc) {
      __builtin_amdgcn_fence(__ATOMIC_RELEASE, "agent");
      asm volatile("s_waitcnt vmcnt(0)" ::: "memory");
      const unsigned og = xb_add(&bar[XB_TOP], 1u);
      const unsigned tg = og / nx;
      if (og + 1u == (tg + 1u) * nx) xb_add(&bar[XB_TOPGEN], 1u);
      else XB_SPIN(xb_ld(&bar[XB_TOPGEN]) == tg, bar);
      __builtin_amdgcn_fence(__ATOMIC_ACQUIRE, "agent");
      xb_add(&bar[XB_XGEN(b.x)], 1u);
      asm volatile("s_waitcnt vmcnt(0)" ::: "memory");
    } else {
      XB_SPIN(xb_ld(&bar[XB_XGEN(b.x)]) == gen, bar);
      __builtin_amdgcn_fence(__ATOMIC_ACQUIRE, "agent");
      asm volatile("s_waitcnt vmcnt(0)" ::: "memory");
    }
  }
  __syncthreads();
}

__global__ void __launch_bounds__(NT) mega(P p) {
  extern __shared__ __attribute__((aligned(16))) char smem[];
#if MULTI_LAUNCH
  __shared__ int sh_next[4];
  for (int ph = p.ph_lo; ph < p.ph_hi; ph++) run_phase(p, ph, smem, sh_next);
#else
  __shared__ uint4 xb_words;
  __shared__ int sh_next[4];
  cg::grid_group grid = cg::this_grid();
  unsigned* bar = (unsigned*)(p.ws + OFF_BAR);
  if (threadIdx.x == 0) xb_words = make_uint4(0u, 0u, 0u, 0u);
  if (blockIdx.x == 0) { for (int i = threadIdx.x; i < 4096; i += NT) __hip_atomic_store(&bar[i], 0u, __ATOMIC_RELAXED, __HIP_MEMORY_SCOPE_AGENT); }
  __syncthreads();
  XcdBarrier xb;
  for (int ph = p.ph_lo; ph < p.ph_hi; ph++) {
    const int reps = (ph >= 2 && ((p.rep_mask >> ((ph - 2) % 9)) & 1)) ? 2 : 1;
    for (int rp = 0; rp < reps; rp++) { run_phase(p, ph, smem, sh_next); if (rp + 1 < reps) xcd_barrier(xb); }
    if (ph + 1 < p.ph_hi) {
      if (ph == p.ph_lo) { grid.sync(); xb = xcd_barrier_post(bar, (volatile LAS unsigned*)&xb_words); }
      else xcd_barrier(xb);
    }
  }
#endif
}

extern "C" void kernel_launch(void* const* d_in, const int* in_sizes, int n_in, void* d_out, int out_size, void* d_ws, size_t ws_size, hipStream_t stream) {
  static int grid_blocks = 0;
  if (!grid_blocks) {
    int dev = 0, cus = 0, per_cu = 0;
    hipGetDevice(&dev);
    hipDeviceGetAttribute(&cus, hipDeviceAttributeMultiprocessorCount, dev);
    hipFuncSetAttribute((const void*)mega, hipFuncAttributeMaxDynamicSharedMemorySize, SMEM_BYTES);
    hipOccupancyMaxActiveBlocksPerMultiprocessor(&per_cu, (const void*)mega, NT, SMEM_BYTES);
    if (per_cu < 1) per_cu = 1;
    grid_blocks = cus * per_cu;
    if (ws_size < WS_END) fprintf(stderr, "workspace too small: %zu < %zu\n", ws_size, (size_t)WS_END);
  }
  P p{};
  for (int i = 0; i < 25; i++) p.in[i] = (const float*)d_in[i];
  p.out = (float*)d_out;
  p.ws = (char*)d_ws;
  for (int i = 0; i < 32; i++) p.invf[i] = pow(10000.0, -(double)i / 32.0);
  {
    const double c[16] = {-1.0 / 6, 1.0 / 120, -1.0 / 5040, 1.0 / 362880, -1.0 / 39916800, 1.0 / 6227020800.0,
                          -0.5, 1.0 / 24, -1.0 / 720, 1.0 / 40320, -1.0 / 3628800, 1.0 / 479001600.0, -1.0 / 87178291200.0,
                          0.6366197723675814, 1.5707963267948966, 6.123233995736766e-17};
    for (int i = 0; i < 16; i++) p.cf[i] = c[i];
  }
#if MULTI_LAUNCH
  for (int ph = 0; ph < N_PHASES; ph++) {
    p.ph_lo = ph; p.ph_hi = ph + 1;
    hipLaunchKernelGGL(mega, dim3(grid_blocks), dim3(NT), SMEM_BYTES, stream, p);
  }
#else
  p.ph_lo = 0; p.ph_hi = N_PHASES; p.rep_mask = REPMASK;
  void* args[] = {&p};
  hipError_t e = hipLaunchCooperativeKernel((const void*)mega, dim3(grid_blocks), dim3(NT), args, SMEM_BYTES, stream);
  if (e != hipSuccess) fprintf(stderr, "cooperative launch failed: %s (grid %d)\n", hipGetErrorString(e), grid_blocks);
#endif
}
```

```cpp
#include <hip/hip_runtime.h>
#include <hip/hip_bf16.h>
#include <hip/hip_cooperative_groups.h>
#include <cstdio>
#include <cmath>
namespace cg = cooperative_groups;

#ifndef REPMASK
#define REPMASK 0
#endif
#ifndef MULTI_LAUNCH
#define MULTI_LAUNCH 0
#endif

typedef unsigned short u16;
using bf16x8 = __attribute__((ext_vector_type(8))) short;
using f32x16 = __attribute__((ext_vector_type(16))) float;
using f32x4 = __attribute__((ext_vector_type(4))) float;
#define DI __device__ __forceinline__

constexpr int NT = 512;
constexpr int T_ = 32768, S_ = 8192, D_ = 1024, PW = 2944, DFF = 4096;
constexpr float NEGF = -1e30f;
constexpr float DN_ALPHA = 1.681792830507429f;

constexpr size_t OFF_WIN = 0;
constexpr int NPI = 3072;
constexpr size_t OFF_WO  = OFF_WIN + 4ull * NPI * 1024 * 2;
constexpr size_t OFF_FF1 = OFF_WO + 4ull * 1024 * 1024 * 2;
constexpr size_t OFF_FF2 = OFF_FF1 + 4ull * 4096 * 1024 * 2;
constexpr size_t OFF_CW1 = OFF_FF2 + 4ull * 4096 * 1024 * 2;
constexpr size_t OFF_CW2 = OFF_CW1 + 4ull * 2 * 256 * 2048 * 2;
constexpr size_t OFF_MOD = OFF_CW2 + 4ull * 2 * 128 * 256 * 2;
constexpr size_t OFF_COS = OFF_MOD + 4ull * 4 * 6144 * 4;
constexpr size_t OFF_SIN = OFF_COS + (size_t)T_ * 32 * 4;
constexpr size_t OFF_LB  = OFF_SIN + (size_t)T_ * 32 * 4;
constexpr size_t OFF_CB  = OFF_LB + 4096;
constexpr size_t OFF_BAR = OFF_CB + 8192;
constexpr size_t OFF_WSB = OFF_BAR + 16384;
constexpr size_t OFF_H   = OFF_WSB + 524288;
constexpr size_t OFF_BIG = OFF_H + (size_t)T_ * 1024 * 2;
constexpr size_t OFF_MIX = OFF_BIG + (size_t)T_ * PW * 2;
constexpr size_t OFF_BIGEND = OFF_BIG + (size_t)T_ * 4096 * 2;
constexpr size_t OFF_VTS = OFF_BIGEND;
constexpr size_t OFF_VTW = OFF_VTS + 8388608;
constexpr size_t OFF_ST  = OFF_VTW + 8388608;
constexpr size_t OFF_DEC = OFF_ST + 33554432;
constexpr size_t OFF_CH  = OFF_DEC + 524288;
constexpr size_t OFF_KC  = OFF_CH + 4194304;
constexpr size_t OFF_VCT = OFF_KC + 524288;
constexpr size_t OFF_YL  = OFF_VTS;
constexpr size_t WS_END  = OFF_YL + (size_t)T_ * 1024 * 2;

struct P {
  const float* in[25];
  float* out;
  char* ws;
  double invf[32];
  double cf[16];
  int ph_lo, ph_hi;
  int rep_mask, pad_;
};

DI u16 f2bf(float x) { unsigned u = __float_as_uint(x); u += 0x7fffu + ((u >> 16) & 1u); return (u16)(u >> 16); }
DI float bf2f(u16 h) { return __uint_as_float(((unsigned)h) << 16); }
typedef __bf16 bf2_t __attribute__((ext_vector_type(2)));
typedef float f2_t __attribute__((ext_vector_type(2)));
DI unsigned pack2(float a, float b) { f2_t v = {a, b}; bf2_t r = __builtin_convertvector(v, bf2_t); return __builtin_bit_cast(unsigned, r); }
typedef _Float16 h8_t __attribute__((ext_vector_type(8)));
typedef _Float16 h2_t __attribute__((ext_vector_type(2)));
typedef float f2h_t __attribute__((ext_vector_type(2)));
DI unsigned pack2h(float a, float b) { f2h_t v = {a, b}; h2_t r = __builtin_convertvector(v, h2_t); return __builtin_bit_cast(unsigned, r); }
DI float hlo2f(unsigned u) { return (float)__builtin_bit_cast(_Float16, (unsigned short)(u & 0xffffu)); }
DI float hhi2f(unsigned u) { return (float)__builtin_bit_cast(_Float16, (unsigned short)(u >> 16)); }
DI float lo2f(unsigned u) { return __uint_as_float(u << 16); }
DI float hi2f(unsigned u) { return __uint_as_float(u & 0xffff0000u); }
DI int tidx() { int t = threadIdx.x; asm volatile("" : "+v"(t)); return t; }
DI float sigm(float x) { return 1.f / (1.f + __expf(-x)); }
DI float silu(float x) { return x / (1.f + __expf(-x)); }
DI float gelu_t(float x) { float u = 0.7978845608028654f * (x + 0.044715f * x * x * x); return x / (1.f + __expf(-2.f * u)); }
DI f32x16 mfma32(bf16x8 a, bf16x8 b, f32x16 c) { return __builtin_amdgcn_mfma_f32_32x32x16_bf16(a, b, c, 0, 0, 0); }
DI f32x4 mfma16(bf16x8 a, bf16x8 b, f32x4 c) { return __builtin_amdgcn_mfma_f32_16x16x32_bf16(a, b, c, 0, 0, 0); }
DI float wsum(float v) { for (int o = 32; o > 0; o >>= 1) v += __shfl_xor(v, o); return v; }
DI void unpack8(uint4 r, float* f) {
  f[0] = lo2f(r.x); f[1] = hi2f(r.x); f[2] = lo2f(r.y); f[3] = hi2f(r.y);
  f[4] = lo2f(r.z); f[5] = hi2f(r.z); f[6] = lo2f(r.w); f[7] = hi2f(r.w);
}

constexpr int BM = 256, BN = 128, BK = 64, LDT = 72;
constexpr int SMEM_BYTES = 147456;

struct APlain { const u16* A; int lda; DI const u16* operator()(int row, int kt) const { return A + (size_t)row * lda + kt * 64; } };
struct ACmp { const u16* proj; int col0;
  DI const u16* operator()(int row, int kt) const {
    int n = row & 511, bh = row >> 9, b = bh >> 1, hk = bh & 1;
    int s = 16 * n + kt; s = s < S_ ? s : S_ - 1;
    return proj + (size_t)(b * S_ + s) * PW + col0 + hk * 64;
  } };

template <class AF, class EF>
DI void gemm_tile(AF af, const u16* __restrict__ Bt, int K, int m0, int n0, EF ef, char* smem) {
  u16* sA = (u16*)smem;
  u16* sB = sA + 2 * BM * LDT;
  const int tid = tidx(), lane = tid & 63, wid = tid >> 6, wm = wid >> 1, wn = wid & 1;
  const int cr = tid >> 3, cc = (tid & 7) * 8;
  f32x16 acc[2][2];
#pragma unroll
  for (int i = 0; i < 2; i++)
#pragma unroll
    for (int j = 0; j < 2; j++)
#pragma unroll
      for (int r = 0; r < 16; r++) acc[i][j][r] = 0.f;
  uint4 ra[4], rb[2];
  const int nk = K / BK;
#pragma unroll
  for (int i = 0; i < 4; i++) ra[i] = *(const uint4*)(af(m0 + cr + i * 64, 0) + cc);
#pragma unroll
  for (int i = 0; i < 2; i++) rb[i] = *(const uint4*)(Bt + (size_t)(n0 + cr + i * 64) * K + cc);
#pragma unroll
  for (int i = 0; i < 4; i++) *(uint4*)(sA + (cr + i * 64) * LDT + cc) = ra[i];
#pragma unroll
  for (int i = 0; i < 2; i++) *(uint4*)(sB + (cr + i * 64) * LDT + cc) = rb[i];
  __syncthreads();
  for (int kt = 0; kt < nk; kt++) {
    const int cur = kt & 1;
    if (kt + 1 < nk) {
#pragma unroll
      for (int i = 0; i < 4; i++) ra[i] = *(const uint4*)(af(m0 + cr + i * 64, kt + 1) + cc);
#pragma unroll
      for (int i = 0; i < 2; i++) rb[i] = *(const uint4*)(Bt + (size_t)(n0 + cr + i * 64) * K + (kt + 1) * 64 + cc);
    }
    const u16* a_ = sA + cur * BM * LDT + (wm * 64 + (lane & 31)) * LDT + (lane >> 5) * 8;
    const u16* b_ = sB + cur * BN * LDT + (wn * 64 + (lane & 31)) * LDT + (lane >> 5) * 8;
#pragma unroll
    for (int ks = 0; ks < 4; ks++) {
      bf16x8 fa0 = *(const bf16x8*)(a_ + ks * 16), fa1 = *(const bf16x8*)(a_ + 32 * LDT + ks * 16);
      bf16x8 fb0 = *(const bf16x8*)(b_ + ks * 16), fb1 = *(const bf16x8*)(b_ + 32 * LDT + ks * 16);
      acc[0][0] = mfma32(fb0, fa0, acc[0][0]);
      acc[0][1] = mfma32(fb1, fa0, acc[0][1]);
      acc[1][0] = mfma32(fb0, fa1, acc[1][0]);
      acc[1][1] = mfma32(fb1, fa1, acc[1][1]);
    }
    if (kt + 1 < nk) {
      u16* dA = sA + (cur ^ 1) * BM * LDT;
      u16* dB = sB + (cur ^ 1) * BN * LDT;
#pragma unroll
      for (int i = 0; i < 4; i++) *(uint4*)(dA + (cr + i * 64) * LDT + cc) = ra[i];
#pragma unroll
      for (int i = 0; i < 2; i++) *(uint4*)(dB + (cr + i * 64) * LDT + cc) = rb[i];
    }
    __syncthreads();
  }
  ef(m0 + wm * 64, n0 + wn * 64, acc, lane);
}

struct EpiPlain {
  u16* out; int ldo; int act; const float* bias;
  DI void operator()(int tm0, int tn0, f32x16 (&acc)[2][2], int lane) const {
    const int h = lane >> 5;
#pragma unroll
    for (int mi = 0; mi < 2; mi++) {
      const size_t row = (size_t)(tm0 + mi * 32 + (lane & 31));
#pragma unroll
      for (int ni = 0; ni < 2; ni++)
#pragma unroll
        for (int q = 0; q < 4; q++) {
          const int col = tn0 + ni * 32 + 8 * q + 4 * h;
          float v[4];
#pragma unroll
          for (int j = 0; j < 4; j++) {
            float x = acc[mi][ni][4 * q + j];
            if (act == 1) { x = fmaxf(x, 0.f); x = x * x; }
            else if (act == 2) { x = gelu_t(x + bias[col + j]); }
            v[j] = x;
          }
          uint2 pk; pk.x = pack2(v[0], v[1]); pk.y = pack2(v[2], v[3]);
          *(uint2*)(out + row * ldo + col) = pk;
        }
    }
  }
};

struct EpiInProj {
  u16* proj; u16* vts; u16* vtw; const float* cs; const float* sn;
  DI void operator()(int tm0, int tn0, f32x16 (&acc)[2][2], int lane) const {
    const int h = lane >> 5;
    const bool isrope = (tn0 >= 1024 && tn0 < 1664) || (tn0 >= 1792 && tn0 < 1920) || (tn0 >= 2048 && tn0 < 2176);
    const float scale = (tn0 >= 1024 && tn0 < 1536) ? 0.125f : 1.f;
    const bool isvts = (tn0 >= 1920 && tn0 < 2048), isvtw = (tn0 >= 2176 && tn0 < 2304);
#pragma unroll
    for (int mi = 0; mi < 2; mi++) {
      const int token = tm0 + mi * 32 + (lane & 31);
      if (isrope) {
#pragma unroll
        for (int q = 0; q < 4; q++) {
          const int d0 = 8 * q + 4 * h;
          const float4 c4 = *(const float4*)(cs + (size_t)token * 32 + d0);
          const float4 s4 = *(const float4*)(sn + (size_t)token * 32 + d0);
          const float cc[4] = {c4.x, c4.y, c4.z, c4.w}, ss[4] = {s4.x, s4.y, s4.z, s4.w};
#pragma unroll
          for (int j = 0; j < 4; j++) {
            const float a1 = acc[mi][0][4 * q + j], a2 = acc[mi][1][4 * q + j];
            acc[mi][0][4 * q + j] = (a1 * cc[j] - a2 * ss[j]) * scale;
            acc[mi][1][4 * q + j] = (a2 * cc[j] + a1 * ss[j]) * scale;
          }
        }
      }
      if (isvts || isvtw) {
        const int b = token / S_, s = token % S_;
        const int hk = ((tn0 - (isvts ? 1920 : 2176)) >> 6);
        u16* vt = (isvts ? vts : vtw) + (size_t)((b * 2 + hk) * 64) * S_ + s;
#pragma unroll
        for (int ni = 0; ni < 2; ni++)
#pragma unroll
          for (int r = 0; r < 16; r++) {
            const int dim = ni * 32 + 8 * (r >> 2) + 4 * h + (r & 3);
            vt[(size_t)dim * S_] = f2bf(acc[mi][ni][r]);
          }
      } else {
#pragma unroll
        for (int ni = 0; ni < 2; ni++)
#pragma unroll
          for (int q = 0; q < 4; q++) {
            const int col = tn0 + ni * 32 + 8 * q + 4 * h;
            uint2 pk; pk.x = pack2(acc[mi][ni][4 * q], acc[mi][ni][4 * q + 1]); pk.y = pack2(acc[mi][ni][4 * q + 2], acc[mi][ni][4 * q + 3]);
            *(uint2*)(proj + (size_t)token * PW + col) = pk;
          }
      }
    }
  }
};

struct EpiCmp2 {
  u16* kc; u16* vct; int kv;
  DI void operator()(int tm0, int tn0, f32x16 (&acc)[2][2], int lane) const {
    if (tn0 >= 64) return;
    const int h = lane >> 5;
#pragma unroll
    for (int mi = 0; mi < 2; mi++) {
      const int row = tm0 + mi * 32 + (lane & 31);
      const int n = row & 511, bh = row >> 9;
#pragma unroll
      for (int ni = 0; ni < 2; ni++)
#pragma unroll
        for (int r = 0; r < 16; r++) {
          const int dim = ni * 32 + 8 * (r >> 2) + 4 * h + (r & 3);
          const u16 v = f2bf(acc[mi][ni][r]);
          if (kv == 0) kc[(size_t)row * 64 + dim] = v;
          else vct[(size_t)(bh * 64 + dim) * 512 + n] = v;
        }
    }
  }
};


constexpr int G_BK = 64, G_HALF = 128, G_HT = G_HALF * G_BK;
constexpr int G_SHM = 8 * G_HT * 2;
DI int g_lds_byte(int r, int c) {
  int st = (r >> 4) * 2 + (c >> 5), rr = r & 15, cc = c & 31, ob = rr * 64 + cc * 2;
  return st * 1024 + (ob ^ (((ob >> 9) & 1) << 5));
}
DI void g_stage_rc(int b, int& R, int& C) {
  int st = b / 1024, sb = b % 1024, swz = sb ^ (((sb >> 9) & 1) << 5);
  R = (st >> 1) * 16 + swz / 64; C = (st & 1) * 32 + (swz % 64) / 2;
}
template <bool F16, class EF>
DI void gemm256_tile(const u16* __restrict__ A, const u16* __restrict__ Bt, int K, int brow, int bcol, EF ef, char* smem) {
  u16* shm = (u16*)smem;
  const int tid = tidx();
#define SA(b, h) (shm + ((b) * 2 + (h)) * G_HT)
#define SB(b, h) (shm + (4 + (b) * 2 + (h)) * G_HT)
#define STAGE(P_, BASE, br, kt) do { const u16* _gb = (BASE) + ((long)(br) * K + (long)(kt) * G_BK); \
    __builtin_amdgcn_global_load_lds((const unsigned*)(_gb + so0), (__attribute__((address_space(3))) unsigned*)((char*)(P_) + tid * 16), 16, 0, 0); \
    __builtin_amdgcn_global_load_lds((const unsigned*)(_gb + so1), (__attribute__((address_space(3))) unsigned*)((char*)(P_) + tid * 16 + 8192), 16, 0, 0); } while (0)
#define LDA(dst, b, h) for (int m = 0; m < 4; ++m) for (int k = 0; k < 2; ++k) \
    dst[m][k] = *reinterpret_cast<const bf16x8*>((char*)SA(b, h) + g_lds_byte(wr * 64 + m * 16 + fr, k * 32 + fq * 8))
#define LDB(dst, b, h) for (int n = 0; n < 2; ++n) for (int k = 0; k < 2; ++k) \
    dst[n][k] = *reinterpret_cast<const bf16x8*>((char*)SB(b, h) + g_lds_byte(wc * 32 + n * 16 + fr, k * 32 + fq * 8))
#define MMA(ai, bj, At_, Bt_) do { __builtin_amdgcn_s_setprio(1); \
    for (int m = 0; m < 4; ++m) for (int n = 0; n < 2; ++n) for (int k = 0; k < 2; ++k) \
      acc[ai][bj][m][n] = F16 ? __builtin_amdgcn_mfma_f32_16x16x32_f16(__builtin_bit_cast(h8_t, At_[m][k]), __builtin_bit_cast(h8_t, Bt_[n][k]), acc[ai][bj][m][n], 0, 0, 0) \
                              : __builtin_amdgcn_mfma_f32_16x16x32_bf16(At_[m][k], Bt_[n][k], acc[ai][bj][m][n], 0, 0, 0); \
    __builtin_amdgcn_s_setprio(0); } while (0)
#define WAIT_V(n) asm volatile("s_waitcnt vmcnt(" #n ")" ::: "memory")
#define WAIT_L(n) asm volatile("s_waitcnt lgkmcnt(" #n ")" ::: "memory")
#define BAR __builtin_amdgcn_s_barrier()
#define SCHED __builtin_amdgcn_sched_barrier(0)
  const int wid = tid >> 6, lane = tid & 63, wr = wid >> 2, wc = wid & 3, fr = lane & 15, fq = lane >> 4;
  unsigned so0, so1;
  { int r_, c_; g_stage_rc(tid * 16, r_, c_); so0 = (unsigned)(r_ * K + c_); g_stage_rc(tid * 16 + 8192, r_, c_); so1 = (unsigned)(r_ * K + c_); }
  f32x4 acc[2][2][4][2] = {};
  bf16x8 At[4][2], B0[2][2], B1[2][2];
  const int nt = K / G_BK;
  STAGE(SB(0, 0), Bt, bcol, 0); STAGE(SA(0, 0), A, brow, 0);
  STAGE(SB(0, 1), Bt, bcol + G_HALF, 0); STAGE(SA(0, 1), A, brow + G_HALF, 0);
  if (wr == 1) BAR;
  WAIT_V(4); BAR;
  STAGE(SB(1, 0), Bt, bcol, 1); STAGE(SA(1, 0), A, brow, 1); STAGE(SB(1, 1), Bt, bcol + G_HALF, 1);
  WAIT_V(6); BAR;
  for (int t = 0; t < nt - 2; t += 2) {
    LDB(B0, 0, 0); SCHED; LDA(At, 0, 0); STAGE(SA(1, 1), A, brow + G_HALF, t + 1);
    WAIT_L(8); BAR; WAIT_L(0); MMA(0, 0, At, B0); BAR; SCHED;
    LDB(B1, 0, 1); STAGE(SB(0, 0), Bt, bcol, t + 2);
    BAR; WAIT_L(0); MMA(0, 1, At, B1); BAR;
    LDA(At, 0, 1); STAGE(SA(0, 0), A, brow, t + 2);
    BAR; WAIT_L(0); MMA(1, 0, At, B0); BAR; SCHED;
    STAGE(SB(0, 1), Bt, bcol + G_HALF, t + 2);
    WAIT_V(6); BAR; MMA(1, 1, At, B1); BAR;
    LDB(B0, 1, 0); SCHED; LDA(At, 1, 0); STAGE(SA(0, 1), A, brow + G_HALF, t + 2);
    WAIT_L(8); BAR; WAIT_L(0); MMA(0, 0, At, B0); BAR; SCHED;
    LDB(B1, 1, 1); STAGE(SB(1, 0), Bt, bcol, t + 3);
    BAR; WAIT_L(0); MMA(0, 1, At, B1); BAR;
    LDA(At, 1, 1); STAGE(SA(1, 0), A, brow, t + 3);
    BAR; WAIT_L(0); MMA(1, 0, At, B0); BAR; SCHED;
    STAGE(SB(1, 1), Bt, bcol + G_HALF, t + 3);
    WAIT_V(6); BAR; MMA(1, 1, At, B1); BAR;
  }
  { LDB(B0, 0, 0); LDA(At, 0, 0); STAGE(SA(1, 1), A, brow + G_HALF, nt - 1);
    BAR; WAIT_L(0); MMA(0, 0, At, B0); BAR;
    LDB(B1, 0, 1); BAR; WAIT_L(0); MMA(0, 1, At, B1); BAR;
    LDA(At, 0, 1); WAIT_V(4); BAR; WAIT_L(0); MMA(1, 0, At, B0); MMA(1, 1, At, B1); BAR; }
  { LDB(B0, 1, 0); LDA(At, 1, 0); WAIT_V(2); BAR; WAIT_L(0); MMA(0, 0, At, B0); BAR;
    LDB(B1, 1, 1); WAIT_V(0); BAR; WAIT_L(0); MMA(0, 1, At, B1); BAR;
    LDA(At, 1, 1); BAR; WAIT_L(0); MMA(1, 0, At, B0); MMA(1, 1, At, B1); BAR; }
  if (wr == 0) BAR;
  ef(brow + wr * 64, bcol + wc * 32, fr, fq, acc);
  __syncthreads();
#undef SA
#undef SB
#undef STAGE
#undef LDA
#undef LDB
#undef MMA
#undef WAIT_V
#undef WAIT_L
#undef BAR
#undef SCHED
}
DI void g_tile_map(int wgid, int nM, int nN, int& pm, int& pn) {
  const int nwg = nM * nN;
  { int q = nwg / 8, r = nwg % 8, xcd = wgid % 8, off = wgid / 8; wgid = (xcd < r ? xcd * (q + 1) : r * (q + 1) + (xcd - r) * q) + off; }
  const int nig = 8 * nN, gid = wgid / nig, fm = gid * 8, gsz = min(nM - fm, 8);
  pm = fm + ((wgid % nig) % gsz); pn = (wgid % nig) / gsz;
}

struct Epi256Plain {
  u16* out; int ldo; int act;
  DI void operator()(int f0, int t0, int fr, int fq, f32x4 (&acc)[2][2][4][2]) const {
    const int fo = (fq & 1) ? 16 + 4 * (fq - 1) : 4 * fq;
#pragma unroll
    for (int ai = 0; ai < 2; ai++)
#pragma unroll
      for (int bj = 0; bj < 2; bj++)
#pragma unroll
        for (int n = 0; n < 2; n++) {
          const size_t token = (size_t)(t0 + bj * 128 + n * 16 + fr);
#pragma unroll
          for (int mp = 0; mp < 2; mp++) {
            unsigned pa[2], pb[2];
#pragma unroll
            for (int e = 0; e < 2; e++) {
              const int m = mp * 2 + e;
              float v[4];
#pragma unroll
              for (int j = 0; j < 4; j++) { float x = acc[ai][bj][m][n][j]; if (act == 1) { x = fmaxf(x, 0.f); x = x * x; } v[j] = x; }
              if (e == 0) { pa[0] = pack2(v[0], v[1]); pa[1] = pack2(v[2], v[3]); } else { pb[0] = pack2(v[0], v[1]); pb[1] = pack2(v[2], v[3]); }
            }
            auto r0 = __builtin_amdgcn_permlane16_swap(pa[0], pb[0], false, false);
            auto r1 = __builtin_amdgcn_permlane16_swap(pa[1], pb[1], false, false);
            uint4 pk; pk.x = r0[0]; pk.y = r1[0]; pk.z = r0[1]; pk.w = r1[1];
            *(uint4*)(out + token * ldo + f0 + ai * 128 + mp * 32 + fo) = pk;
          }
        }
  }
};

struct Epi256InProj {
  u16* proj; u16* vts; u16* vtw; const float* cs; const float* sn;
  DI void operator()(int f0, int t0, int fr, int fq, f32x4 (&acc)[2][2][4][2]) const {
#pragma unroll
    for (int ai = 0; ai < 2; ai++) {
      const int fb = f0 + ai * 128;
      if (fb >= PW) continue;
      const bool isrope = (fb >= 1024 && fb < 1664) || (fb >= 1792 && fb < 1920) || (fb >= 2048 && fb < 2176);
      const float scale = (fb >= 1024 && fb < 1536) ? 0.125f : 1.f;
      const bool isvts = (fb >= 1920 && fb < 2048), isvtw = (fb >= 2176 && fb < 2304);
#pragma unroll
      for (int bj = 0; bj < 2; bj++)
#pragma unroll
        for (int n = 0; n < 2; n++) {
          const int token = t0 + bj * 128 + n * 16 + fr;
          if (isrope) {
#pragma unroll
            for (int m = 0; m < 2; m++) {
              const int d0 = m * 16 + fq * 4;
              const float4 c4 = *(const float4*)(cs + (size_t)token * 32 + d0);
              const float4 s4 = *(const float4*)(sn + (size_t)token * 32 + d0);
              const float cc[4] = {c4.x, c4.y, c4.z, c4.w}, ss[4] = {s4.x, s4.y, s4.z, s4.w};
#pragma unroll
              for (int j = 0; j < 4; j++) {
                const float a1 = acc[ai][bj][m][n][j], a2 = acc[ai][bj][m + 2][n][j];
                acc[ai][bj][m][n][j] = (a1 * cc[j] - a2 * ss[j]) * scale;
                acc[ai][bj][m + 2][n][j] = (a2 * cc[j] + a1 * ss[j]) * scale;
              }
            }
          }
          if (isvts || isvtw) {
            const int b = token / S_, s = token % S_;
            const int hk = ((fb - (isvts ? 1920 : 2176)) >> 6);
            u16* vt = (isvts ? vts : vtw) + (size_t)((b * 2 + hk) * 64) * S_ + s;
#pragma unroll
            for (int m = 0; m < 4; m++)
#pragma unroll
              for (int j = 0; j < 4; j++) vt[(size_t)(m * 16 + fq * 4 + j) * S_] = f2bf(acc[ai][bj][m][n][j]);
          } else {
            const int fo = (fq & 1) ? 16 + 4 * (fq - 1) : 4 * fq;
#pragma unroll
            for (int mp = 0; mp < 2; mp++) {
              const unsigned a0 = pack2(acc[ai][bj][2 * mp][n][0], acc[ai][bj][2 * mp][n][1]), a1 = pack2(acc[ai][bj][2 * mp][n][2], acc[ai][bj][2 * mp][n][3]);
              const unsigned b0 = pack2(acc[ai][bj][2 * mp + 1][n][0], acc[ai][bj][2 * mp + 1][n][1]), b1 = pack2(acc[ai][bj][2 * mp + 1][n][2], acc[ai][bj][2 * mp + 1][n][3]);
              auto r0 = __builtin_amdgcn_permlane16_swap(a0, b0, false, false);
              auto r1 = __builtin_amdgcn_permlane16_swap(a1, b1, false, false);
              uint4 pk; pk.x = r0[0]; pk.y = r1[0]; pk.z = r0[1]; pk.w = r1[1];
              *(uint4*)(proj + (size_t)token * PW + fb + mp * 32 + fo) = pk;
            }
          }
        }
    }
  }
};

DI void transpose_tile(const float* __restrict__ W, int K, int N, u16* __restrict__ dst, int kt, int nt_, char* smem) {
  float* tile = (float*)smem;
  const int tid = tidx();
  const int k0 = kt * 64, n0 = nt_ * 64;
  {
    const int r = tid >> 4, c4 = (tid & 15) * 4;
#pragma unroll
    for (int rr = 0; rr < 2; rr++) {
      const int k = r + rr * 32;
      float4 v = make_float4(0.f, 0.f, 0.f, 0.f);
      if (n0 + c4 < N) v = *(const float4*)(W + (size_t)(k0 + k) * N + n0 + c4);
      tile[k * 65 + c4] = v.x; tile[k * 65 + c4 + 1] = v.y; tile[k * 65 + c4 + 2] = v.z; tile[k * 65 + c4 + 3] = v.w;
    }
  }
  __syncthreads();
  {
    const int n = tid >> 3, k8 = (tid & 7) * 8;
    uint4 o;
    o.x = pack2(tile[(k8 + 0) * 65 + n], tile[(k8 + 1) * 65 + n]);
    o.y = pack2(tile[(k8 + 2) * 65 + n], tile[(k8 + 3) * 65 + n]);
    o.z = pack2(tile[(k8 + 4) * 65 + n], tile[(k8 + 5) * 65 + n]);
    o.w = pack2(tile[(k8 + 6) * 65 + n], tile[(k8 + 7) * 65 + n]);
    *(uint4*)(dst + (size_t)(n0 + n) * K + k0 + k8) = o;
  }
  __syncthreads();
}

struct TJob { const float* W; int K, N; u16* dst; int kt, nt; int f16; };
DI void transpose_pair(const TJob& ja, const TJob& jb, char* smem) {
  float* tile = (float*)smem;
  const int tid = tidx();
  const int r = tid >> 4, c4 = (tid & 15) * 4;
  float4 va[2], vb[2];
#pragma unroll
  for (int rr = 0; rr < 2; rr++) {
    const int k = r + rr * 32;
    va[rr] = make_float4(0.f, 0.f, 0.f, 0.f); vb[rr] = va[rr];
    if (ja.nt * 64 + c4 < ja.N) va[rr] = *(const float4*)(ja.W + (size_t)(ja.kt * 64 + k) * ja.N + ja.nt * 64 + c4);
    if (jb.nt * 64 + c4 < jb.N) vb[rr] = *(const float4*)(jb.W + (size_t)(jb.kt * 64 + k) * jb.N + jb.nt * 64 + c4);
  }
#pragma unroll
  for (int rr = 0; rr < 2; rr++) {
    const int k = r + rr * 32;
    float* ta = tile + k * 65 + c4; float* tb = ta + 64 * 65;
    ta[0] = va[rr].x; ta[1] = va[rr].y; ta[2] = va[rr].z; ta[3] = va[rr].w;
    tb[0] = vb[rr].x; tb[1] = vb[rr].y; tb[2] = vb[rr].z; tb[3] = vb[rr].w;
  }
  __syncthreads();
  {
    const int n = tid >> 3, k8 = (tid & 7) * 8;
#pragma unroll
    for (int e = 0; e < 2; e++) {
      const float* t = tile + e * 64 * 65;
      const TJob& j = e ? jb : ja;
      uint4 o;
      if (j.f16) {
        o.x = pack2h(t[(k8 + 0) * 65 + n], t[(k8 + 1) * 65 + n]);
        o.y = pack2h(t[(k8 + 2) * 65 + n], t[(k8 + 3) * 65 + n]);
        o.z = pack2h(t[(k8 + 4) * 65 + n], t[(k8 + 5) * 65 + n]);
        o.w = pack2h(t[(k8 + 6) * 65 + n], t[(k8 + 7) * 65 + n]);
      } else {
        o.x = pack2(t[(k8 + 0) * 65 + n], t[(k8 + 1) * 65 + n]);
        o.y = pack2(t[(k8 + 2) * 65 + n], t[(k8 + 3) * 65 + n]);
        o.z = pack2(t[(k8 + 4) * 65 + n], t[(k8 + 5) * 65 + n]);
        o.w = pack2(t[(k8 + 6) * 65 + n], t[(k8 + 7) * 65 + n]);
      }
      *(uint4*)(j.dst + (size_t)(j.nt * 64 + n) * j.K + j.kt * 64 + k8) = o;
    }
  }
  __syncthreads();
}

template <int NB, bool SILU>
DI void gemv_tile(const float* __restrict__ a, int lda, const float* __restrict__ W, int K, int N, int n0, const float* bias, float* out, int ldo, char* smem) {
  float* red = (float*)smem;
  const int tid = tidx(), nn = tid & 63, ks = tid >> 6;
  float acc[NB];
#pragma unroll
  for (int r = 0; r < NB; r++) acc[r] = 0.f;
  const int kl = K / 8;
  for (int k = ks * kl; k < (ks + 1) * kl; k++) {
    const float w = W[(size_t)k * N + n0 + nn];
#pragma unroll
    for (int r = 0; r < NB; r++) { float av = a[r * lda + k]; if (SILU) av = silu(av); acc[r] += av * w; }
  }
#pragma unroll
  for (int r = 0; r < NB; r++) red[(ks * NB + r) * 64 + nn] = acc[r];
  __syncthreads();
  if (tid < NB * 64) {
    const int r = tid >> 6;
    float s = 0.f;
#pragma unroll
    for (int j = 0; j < 8; j++) s += red[(j * NB + r) * 64 + nn];
    if (bias) s += bias[n0 + nn];
    out[r * ldo + n0 + nn] = s;
  }
  __syncthreads();
}

constexpr int TR_PER_LAYER = 768 + 256 + 1024 + 1024 + 128 + 128 + 8 + 8;
constexpr int PREP_TR = 4 * TR_PER_LAYER;
constexpr int PREP_MOD = 4 * 96;
constexpr int PREP_CB = 4 * 2 * 4;
constexpr int PREP_ROPE = 512;
constexpr int PREP_WSB = 128;
constexpr int PREP_ITEMS = PREP_TR + PREP_MOD + PREP_CB + PREP_ROPE + PREP_WSB + 1;

DI TJob decode_tr(const P& p, int item) {
  const int l = item / TR_PER_LAYER; int r = item % TR_PER_LAYER;
  TJob j; j.f16 = 0;
  if (r < 768) { j.f16 = 1; j.W = p.in[3] + (size_t)l * 1024 * 2840; j.K = 1024; j.N = 2840; j.dst = (u16*)(p.ws + OFF_WIN) + (size_t)l * NPI * 1024; j.kt = r / 48; j.nt = r % 48; return j; }
  r -= 768;
  if (r < 256) { j.W = p.in[4] + (size_t)l * 1024 * 1024; j.K = 1024; j.N = 1024; j.dst = (u16*)(p.ws + OFF_WO) + (size_t)l * 1024 * 1024; j.kt = r / 16; j.nt = r % 16; return j; }
  r -= 256;
  if (r < 1024) { j.f16 = 1; j.W = p.in[17] + (size_t)l * 1024 * 4096; j.K = 1024; j.N = 4096; j.dst = (u16*)(p.ws + OFF_FF1) + (size_t)l * 4096 * 1024; j.kt = r / 64; j.nt = r % 64; return j; }
  r -= 1024;
  if (r < 1024) { j.W = p.in[18] + (size_t)l * 4096 * 1024; j.K = 4096; j.N = 1024; j.dst = (u16*)(p.ws + OFF_FF2) + (size_t)l * 1024 * 4096; j.kt = r / 16; j.nt = r % 16; return j; }
  r -= 1024;
  if (r < 256) { const int kv = r >> 7; r &= 127; j.W = p.in[kv ? 11 : 8] + (size_t)l * 2048 * 256; j.K = 2048; j.N = 256; j.dst = (u16*)(p.ws + OFF_CW1) + (size_t)(l * 2 + kv) * 256 * 2048; j.kt = r / 4; j.nt = r % 4; return j; }
  r -= 256;
  { const int kv = r >> 3; r &= 7; j.W = p.in[kv ? 12 : 9] + (size_t)l * 256 * 64; j.K = 256; j.N = 64; j.dst = (u16*)(p.ws + OFF_CW2) + (size_t)(l * 2 + kv) * 128 * 256; j.kt = r / 2; j.nt = r % 2; return j; }
}

DI void prep_item(const P& p, int item, char* smem) {
  const int tid = tidx();
  if (item < PREP_TR) { const TJob j = decode_tr(p, item); transpose_pair(j, j, smem); return; }
  item -= PREP_TR;
  if (item < PREP_MOD) {
    const int l = item / 96, nt_ = item % 96;
    gemv_tile<4, true>(p.in[1], 1024, p.in[19] + (size_t)l * 1024 * 6144, 1024, 6144, nt_ * 64, p.in[20] + l * 6144,
                       (float*)(p.ws + OFF_MOD) + (size_t)l * 4 * 6144, 6144, smem);
    return;
  }
  item -= PREP_MOD;
  if (item < PREP_CB) {
    const int l = item >> 3, kv = (item >> 2) & 1, nt_ = item & 3;
    gemv_tile<1, false>(p.in[kv ? 10 : 7] + (size_t)l * 2048, 2048, p.in[kv ? 11 : 8] + (size_t)l * 2048 * 256, 2048, 256, nt_ * 64, nullptr,
                        (float*)(p.ws + OFF_CB) + (l * 2 + kv) * 256, 256, smem);
    return;
  }
  item -= PREP_CB;
  if (item < PREP_ROPE) {
    float* cs = (float*)(p.ws + OFF_COS); float* sn = (float*)(p.ws + OFF_SIN);
    const int* pos = (const int*)p.in[2];
#pragma unroll
    for (int j = 0; j < 4; j++) {
      const int idx = item * 2048 + j * 512 + tid;
      const int tok = idx >> 5, i = idx & 31;
      const double ang = (double)pos[tok] * p.invf[i];
      const double qd = rint(ang * p.cf[13]);
      const double r = (ang - qd * p.cf[14]) - qd * p.cf[15];
      const double r2 = r * r;
      const double sr = r * (1.0 + r2 * (p.cf[0] + r2 * (p.cf[1] + r2 * (p.cf[2] + r2 * (p.cf[3] + r2 * (p.cf[4] + r2 * p.cf[5]))))));
      const double cr = 1.0 + r2 * (p.cf[6] + r2 * (p.cf[7] + r2 * (p.cf[8] + r2 * (p.cf[9] + r2 * (p.cf[10] + r2 * (p.cf[11] + r2 * p.cf[12]))))));
      const int qi = ((int)((long long)qd)) & 3;
      double s_, c_;
      if (qi == 0) { s_ = sr; c_ = cr; } else if (qi == 1) { s_ = cr; c_ = -sr; } else if (qi == 2) { s_ = -sr; c_ = -cr; } else { s_ = -cr; c_ = sr; }
      cs[idx] = (float)c_; sn[idx] = (float)s_;
    }
    return;
  }
  item -= PREP_ROPE;
  if (item < PREP_WSB) {
    const float* src = p.in[15];
    u16* dst = (u16*)(p.ws + OFF_WSB);
#pragma unroll
    for (int j = 0; j < 4; j++) {
      const int idx = item * 2048 + j * 512 + tid;
      const int t_ = (idx >> 7) & 127, s_ = idx & 127;
      dst[idx] = f2bf(s_ <= t_ ? src[idx] : 0.f);
    }
    return;
  }
  if (tid < 256) {
    const float* lbr = p.in[5];
    float v[4], m = -1e30f;
#pragma unroll
    for (int l = 0; l < 4; l++) { v[l] = lbr[l * 256 + tid]; m = fmaxf(m, v[l]); }
    float s = 0.f;
#pragma unroll
    for (int l = 0; l < 4; l++) { v[l] = __expf(v[l] - m); s += v[l]; }
    float* lb = (float*)(p.ws + OFF_LB);
    float cum = 0.f;
#pragma unroll
    for (int l = 0; l < 4; l++) { if (l > 0) cum += v[l] / s; lb[l * 256 + tid] = cum; }
  }
}

DI void ln_rows(const P& p, int layer, int mode, int item) {
  const int tid_ = tidx(); const int lane = tid_ & 63, wid = tid_ >> 6;
  const int row = (mode == 0) ? item * 8 + wid : item * 32 + wid * 4;
  const int b = row / S_;
  const float* mod = (const float*)(p.ws + OFF_MOD);
  u16* hb = (u16*)(p.ws + OFF_H) + (size_t)row * 1024;
  if (mode == 0) {
    const float* x = p.in[0] + (size_t)row * 1024;
    const float* md = mod + (size_t)(0 * 4 + b) * 6144;
#pragma unroll
    for (int i = 0; i < 4; i++) {
      const int col = i * 256 + lane * 4;
      const float4 xv = *(const float4*)(x + col);
      const float4 sh = *(const float4*)(md + col), sc = *(const float4*)(md + 1024 + col);
      uint2 pk; pk.x = pack2h(xv.x * (1.f + sc.x) + sh.x, xv.y * (1.f + sc.y) + sh.y); pk.y = pack2h(xv.z * (1.f + sc.z) + sh.z, xv.w * (1.f + sc.w) + sh.w);
      *(uint2*)(hb + col) = pk;
    }
    return;
  }
  constexpr int NR = 4;
  const float* lw = p.in[mode == 1 ? 21 : 23] + layer * 1024;
  const float* lbias = p.in[mode == 1 ? 22 : 24] + layer * 1024;
  const bool has_next = !(mode == 2 && layer == 3);
  const bool from_input = (layer == 0 && mode == 1);
  const u16* ybuf = (mode == 2 && layer == 3) ? (const u16*)(p.ws + OFF_YL) : (const u16*)p.out;
  const float* mdl = mod + (size_t)(layer * 4 + b) * 6144;
  const float* gvec = mdl + (mode == 1 ? 2 : 5) * 1024;
  const float* mprev = mdl + (mode == 1 ? 0 : 3) * 1024;
  const float* mdn = (mode == 1) ? mdl + 3 * 1024 : mod + (size_t)((layer + 1) * 4 + b) * 6144;
  float v[NR][16];
  float s[NR];
#pragma unroll
  for (int rr = 0; rr < NR; rr++) s[rr] = 0.f;
#pragma unroll
  for (int i = 0; i < 2; i++) {
    const int col = i * 512 + lane * 8;
    float gg[8], shv[8], isc[8];
    { const float4 a = *(const float4*)(gvec + col), c2 = *(const float4*)(gvec + col + 4);
      gg[0] = 1.f + a.x; gg[1] = 1.f + a.y; gg[2] = 1.f + a.z; gg[3] = 1.f + a.w; gg[4] = 1.f + c2.x; gg[5] = 1.f + c2.y; gg[6] = 1.f + c2.z; gg[7] = 1.f + c2.w; }
    if (!from_input) {
      const float4 a = *(const float4*)(mprev + col), c2 = *(const float4*)(mprev + col + 4);
      const float4 e = *(const float4*)(mprev + 1024 + col), f = *(const float4*)(mprev + 1024 + col + 4);
      shv[0] = a.x; shv[1] = a.y; shv[2] = a.z; shv[3] = a.w; shv[4] = c2.x; shv[5] = c2.y; shv[6] = c2.z; shv[7] = c2.w;
      isc[0] = 1.f / (1.f + e.x); isc[1] = 1.f / (1.f + e.y); isc[2] = 1.f / (1.f + e.z); isc[3] = 1.f / (1.f + e.w);
      isc[4] = 1.f / (1.f + f.x); isc[5] = 1.f / (1.f + f.y); isc[6] = 1.f / (1.f + f.z); isc[7] = 1.f / (1.f + f.w);
    } else {
#pragma unroll
      for (int j = 0; j < 8; j++) { shv[j] = 0.f; isc[j] = 1.f; }
    }
#pragma unroll
    for (int rr = 0; rr < NR; rr++) {
      const size_t r = (size_t)(row + rr);
      float xv[8], yv[8];
      if (from_input) {
        const float4 a = *(const float4*)(p.in[0] + r * 1024 + col), c2 = *(const float4*)(p.in[0] + r * 1024 + col + 4);
        xv[0] = a.x; xv[1] = a.y; xv[2] = a.z; xv[3] = a.w; xv[4] = c2.x; xv[5] = c2.y; xv[6] = c2.z; xv[7] = c2.w;
      } else {
        const uint4 hr = *(const uint4*)((const u16*)(p.ws + OFF_H) + r * 1024 + col);
        xv[0] = hlo2f(hr.x); xv[1] = hhi2f(hr.x); xv[2] = hlo2f(hr.y); xv[3] = hhi2f(hr.y);
        xv[4] = hlo2f(hr.z); xv[5] = hhi2f(hr.z); xv[6] = hlo2f(hr.w); xv[7] = hhi2f(hr.w);
#pragma unroll
        for (int j = 0; j < 8; j++) xv[j] = (xv[j] - shv[j]) * isc[j];
      }
      unpack8(*(const uint4*)(ybuf + r * 1024 + col), yv);
#pragma unroll
      for (int j = 0; j < 8; j++) { const float t_ = DN_ALPHA * xv[j] + gg[j] * yv[j]; v[rr][i * 8 + j] = t_; s[rr] += t_; }
    }
  }
  float mu[NR], rs[NR];
#pragma unroll
  for (int rr = 0; rr < NR; rr++) mu[rr] = s[rr];
#pragma unroll
  for (int o = 32; o > 0; o >>= 1) {
#pragma unroll
    for (int rr = 0; rr < NR; rr++) mu[rr] += __shfl_xor(mu[rr], o);
  }
#pragma unroll
  for (int rr = 0; rr < NR; rr++) {
    mu[rr] *= (1.f / 1024.f);
    float s2 = 0.f;
#pragma unroll
    for (int i = 0; i < 16; i++) { v[rr][i] -= mu[rr]; s2 += v[rr][i] * v[rr][i]; }
    rs[rr] = s2;
  }
#pragma unroll
  for (int o = 32; o > 0; o >>= 1) {
#pragma unroll
    for (int rr = 0; rr < NR; rr++) rs[rr] += __shfl_xor(rs[rr], o);
  }
#pragma unroll
  for (int rr = 0; rr < NR; rr++) rs[rr] = rsqrtf(rs[rr] * (1.f / 1024.f) + 1e-5f);
#pragma unroll
  for (int i = 0; i < 2; i++) {
    const int col = i * 512 + lane * 8;
    float wv[8], bv[8], shn[8], scn[8];
    { const float4 a = *(const float4*)(lw + col), c2 = *(const float4*)(lw + col + 4), e = *(const float4*)(lbias + col), f = *(const float4*)(lbias + col + 4);
      wv[0] = a.x; wv[1] = a.y; wv[2] = a.z; wv[3] = a.w; wv[4] = c2.x; wv[5] = c2.y; wv[6] = c2.z; wv[7] = c2.w;
      bv[0] = e.x; bv[1] = e.y; bv[2] = e.z; bv[3] = e.w; bv[4] = f.x; bv[5] = f.y; bv[6] = f.z; bv[7] = f.w; }
    if (has_next) {
      const float4 a = *(const float4*)(mdn + col), c2 = *(const float4*)(mdn + col + 4), e = *(const float4*)(mdn + 1024 + col), f = *(const float4*)(mdn + 1024 + col + 4);
      shn[0] = a.x; shn[1] = a.y; shn[2] = a.z; shn[3] = a.w; shn[4] = c2.x; shn[5] = c2.y; shn[6] = c2.z; shn[7] = c2.w;
      scn[0] = 1.f + e.x; scn[1] = 1.f + e.y; scn[2] = 1.f + e.z; scn[3] = 1.f + e.w; scn[4] = 1.f + f.x; scn[5] = 1.f + f.y; scn[6] = 1.f + f.z; scn[7] = 1.f + f.w;
    } else {
#pragma unroll
      for (int j = 0; j < 8; j++) { shn[j] = 0.f; scn[j] = 1.f; }
    }
#pragma unroll
    for (int rr = 0; rr < NR; rr++) {
      const size_t r = (size_t)(row + rr);
      float o[8];
#pragma unroll
      for (int j = 0; j < 8; j++) o[j] = v[rr][i * 8 + j] * rs[rr] * wv[j] + bv[j];
      if (has_next) {
        uint4 pk;
        pk.x = pack2h(o[0] * scn[0] + shn[0], o[1] * scn[1] + shn[1]); pk.y = pack2h(o[2] * scn[2] + shn[2], o[3] * scn[3] + shn[3]);
        pk.z = pack2h(o[4] * scn[4] + shn[4], o[5] * scn[5] + shn[5]); pk.w = pack2h(o[6] * scn[6] + shn[6], o[7] * scn[7] + shn[7]);
        *(uint4*)((u16*)(p.ws + OFF_H) + r * 1024 + col) = pk;
      } else {
        *(float4*)(p.out + r * 1024 + col) = make_float4(o[0], o[1], o[2], o[3]);
        *(float4*)(p.out + r * 1024 + col + 4) = make_float4(o[4], o[5], o[6], o[7]);
      }
    }
  }
}

DI void hgrn_item(const P& p, int layer, int item, int mode, char* smem) {
  const int hh = item & 3, c = (item >> 2) & 127, b = item >> 9;
  const int bh = b * 4 + hh;
  const int tid = tidx();
  float* Bf = (float*)smem;
  float* A1 = Bf + 4096;
  float* At = A1 + 4160;
  float* A2 = At + 4160;
  float* Vs = A2 + 4096;
  float* Sp = Vs + 4096;
  float* seg = Sp + 4096;
  constexpr int HK = 72;
  u16* QdB = (u16*)(A1);
  u16* KdB = QdB + 64 * HK;
  u16* AtB = KdB + 64 * HK;
  u16* VtB = AtB + 64 * HK;
  u16* SpT = VtB + 64 * HK;
  const u16* pr = (const u16*)(p.ws + OFF_BIG) + (size_t)(b * S_ + c * 64) * PW + hh * 64;
  const float* lbp = (const float*)(p.ws + OFF_LB) + layer * 256 + hh * 64;
  float* stp = (float*)(p.ws + OFF_ST) + (size_t)(bh * 128 + c) * 4096;
  const int s = tid >> 3, k8 = (tid & 7) * 8;
  float z[8];
  {
    float vv[8];
    unpack8(*(const uint4*)(pr + (size_t)s * PW + 256 + k8), z);
    unpack8(*(const uint4*)(pr + (size_t)s * PW + 512 + k8), vv);
#pragma unroll
    for (int j = 0; j < 8; j++) {
      const float lb = lbp[k8 + j];
      const float f = lb + (1.f - lb) * sigm(z[j]);
      Bf[s * 64 + k8 + j] = __logf(fmaxf(f, 1e-30f));
      VtB[(k8 + j) * HK + s] = f2bf(vv[j]);
    }
  }
  __syncthreads();
  {
    const int k = tid & 63, sg = tid >> 6;
    float run = 0.f, loc[8];
#pragma unroll
    for (int i = 0; i < 8; i++) { run += Bf[(sg * 8 + i) * 64 + k]; loc[i] = run; }
    seg[sg * 64 + k] = run;
    __syncthreads();
    float pre = 0.f;
    for (int j = 0; j < sg; j++) pre += seg[j * 64 + k];
#pragma unroll
    for (int i = 0; i < 8; i++) Bf[(sg * 8 + i) * 64 + k] = loc[i] + pre;
  }
  __syncthreads();
  if (mode == 0) {
    u16* KdT = KdB;
#pragma unroll
    for (int j = 0; j < 8; j++) {
      const int k = k8 + j;
      const float lb = lbp[k];
      const float kk = (1.f - lb) * sigm(-z[j]);
      KdT[k * HK + s] = f2bf(kk * __expf(Bf[63 * 64 + k] - Bf[s * 64 + k]));
    }
    __syncthreads();
    const int lane = tid & 63, wid = tid >> 6, m = lane & 15, lg = lane >> 4;
    const int kt = wid >> 1;
#pragma unroll
    for (int q = 0; q < 2; q++) {
      const int vt = (wid & 1) * 2 + q;
      f32x4 acc = {0.f, 0.f, 0.f, 0.f};
#pragma unroll
      for (int ks = 0; ks < 2; ks++) {
        const bf16x8 av = *(const bf16x8*)(VtB + (16 * vt + m) * HK + 32 * ks + 8 * lg);
        const bf16x8 bk = *(const bf16x8*)(KdT + (16 * kt + m) * HK + 32 * ks + 8 * lg);
        acc = mfma16(av, bk, acc);
      }
      *(float4*)(stp + (16 * kt + m) * 64 + 16 * vt + 4 * lg) = make_float4(acc[0], acc[1], acc[2], acc[3]);
    }
    if (tid < 64) ((float*)(p.ws + OFF_DEC))[(size_t)(bh * 128 + c) * 64 + tid] = __expf(Bf[63 * 64 + tid]);
    __syncthreads();
    return;
  }
  {
    float qv[8];
    unpack8(*(const uint4*)(pr + (size_t)s * PW + k8), qv);
    float qd[8], kd[8];
#pragma unroll
    for (int j = 0; j < 8; j++) {
      const int k = k8 + j;
      const float lb = lbp[k];
      const float bm = Bf[31 * 64 + k], bb = Bf[s * 64 + k];
      qd[j] = silu(qv[j]) * __expf(bb - bm);
      kd[j] = (1.f - lb) * sigm(-z[j]) * __expf(bm - bb);
    }
    uint4 pq, pk_;
    pq.x = pack2(qd[0], qd[1]); pq.y = pack2(qd[2], qd[3]); pq.z = pack2(qd[4], qd[5]); pq.w = pack2(qd[6], qd[7]);
    pk_.x = pack2(kd[0], kd[1]); pk_.y = pack2(kd[2], kd[3]); pk_.z = pack2(kd[4], kd[5]); pk_.w = pack2(kd[6], kd[7]);
    *(uint4*)(QdB + s * HK + k8) = pq;
    *(uint4*)(KdB + s * HK + k8) = pk_;
    const int k = tid >> 3, v0 = (tid & 7) * 8;
    const float e = __expf(Bf[31 * 64 + k]);
    const float4 sa = *(const float4*)(stp + k * 64 + v0), sb = *(const float4*)(stp + k * 64 + v0 + 4);
    const float sv[8] = {sa.x, sa.y, sa.z, sa.w, sb.x, sb.y, sb.z, sb.w};
#pragma unroll
    for (int i = 0; i < 8; i++) SpT[(v0 + i) * HK + k] = f2bf(sv[i] * e);
  }
  __syncthreads();
  const int lane = tid & 63, wid = tid >> 6, m = lane & 15, lg = lane >> 4;
  {
    const int mt = wid >> 1;
#pragma unroll
    for (int q = 0; q < 2; q++) {
      const int nt = (wid & 1) * 2 + q;
      f32x4 acc = {0.f, 0.f, 0.f, 0.f};
#pragma unroll
      for (int ks = 0; ks < 2; ks++) {
        const bf16x8 af = *(const bf16x8*)(KdB + (16 * nt + m) * HK + 32 * ks + 8 * lg);
        const bf16x8 bfr = *(const bf16x8*)(QdB + (16 * mt + m) * HK + 32 * ks + 8 * lg);
        acc = mfma16(af, bfr, acc);
      }
      const int t_ = 16 * mt + m, s0 = 16 * nt + 4 * lg;
      uint2 pk;
      pk.x = pack2(s0 + 0 <= t_ ? acc[0] : 0.f, s0 + 1 <= t_ ? acc[1] : 0.f);
      pk.y = pack2(s0 + 2 <= t_ ? acc[2] : 0.f, s0 + 3 <= t_ ? acc[3] : 0.f);
      *(uint2*)(AtB + t_ * HK + s0) = pk;
    }
  }
  __syncthreads();
  if (wid < 4) {
    const int mt = wid;
    f32x4 acc[4];
#pragma unroll
    for (int nt = 0; nt < 4; nt++) acc[nt] = (f32x4){0.f, 0.f, 0.f, 0.f};
#pragma unroll
    for (int ks = 0; ks < 2; ks++) {
      const bf16x8 ba = *(const bf16x8*)(AtB + (16 * mt + m) * HK + 32 * ks + 8 * lg);
      const bf16x8 bq = *(const bf16x8*)(QdB + (16 * mt + m) * HK + 32 * ks + 8 * lg);
#pragma unroll
      for (int nt = 0; nt < 4; nt++) {
        const bf16x8 av = *(const bf16x8*)(VtB + (16 * nt + m) * HK + 32 * ks + 8 * lg);
        const bf16x8 as_ = *(const bf16x8*)(SpT + (16 * nt + m) * HK + 32 * ks + 8 * lg);
        acc[nt] = mfma16(av, ba, acc[nt]);
        acc[nt] = mfma16(as_, bq, acc[nt]);
      }
    }
    float ssq = 0.f;
#pragma unroll
    for (int nt = 0; nt < 4; nt++) ssq += acc[nt][0] * acc[nt][0] + acc[nt][1] * acc[nt][1] + acc[nt][2] * acc[nt][2] + acc[nt][3] * acc[nt][3];
    ssq += __shfl_xor(ssq, 16); ssq += __shfl_xor(ssq, 32);
    const float rn = rsqrtf(ssq * (1.f / 64.f) + 1e-6f);
    const int t_ = 16 * mt + m;
    const float* nw = p.in[6] + layer * 64;
#pragma unroll
    for (int nt = 0; nt < 4; nt++) {
      const int v0 = 16 * nt + 4 * lg;
      const uint2 gr = *(const uint2*)(pr + (size_t)t_ * PW + 768 + v0);
      const float4 n4 = *(const float4*)(nw + v0);
      uint2 pk;
      pk.x = pack2(acc[nt][0] * rn * n4.x * silu(lo2f(gr.x)), acc[nt][1] * rn * n4.y * silu(hi2f(gr.x)));
      pk.y = pack2(acc[nt][2] * rn * n4.z * silu(lo2f(gr.y)), acc[nt][3] * rn * n4.w * silu(hi2f(gr.y)));
      *(uint2*)((u16*)(p.ws + OFF_MIX) + (size_t)(b * S_ + c * 64 + t_) * 1024 + hh * 64 + v0) = pk;
    }
  }
  __syncthreads();
}

DI void scan_item(const P& p, int item) {
  const int tid = tidx();
  if (tid >= 256) return;
  const int gid = item * 256 + tid;
  const int bh = gid >> 12, e = gid & 4095;
  float* st = (float*)(p.ws + OFF_ST) + (size_t)bh * 128 * 4096 + e;
  const float* dc = (const float*)(p.ws + OFF_DEC) + (size_t)bh * 128 * 64 + (e >> 6);
  float carry = 0.f;
  for (int c0 = 0; c0 < 128; c0 += 16) {
    float tmp[16], d[16];
#pragma unroll
    for (int j = 0; j < 16; j++) { tmp[j] = st[(size_t)(c0 + j) * 4096]; d[j] = dc[(c0 + j) * 64]; }
#pragma unroll
    for (int j = 0; j < 16; j++) { st[(size_t)(c0 + j) * 4096] = carry; carry = d[j] * carry + tmp[j]; }
  }
}

DI void gmlp_item(const P& p, int layer, int item, char* smem) {
  constexpr int KS = 136;
  const int g = item & 3, ch = (item >> 2) & 63, b = item >> 8;
  const int tid = tidx(), lane = tid & 63, wid = tid >> 6;
  u16* VnT = (u16*)smem;
  const size_t tok0 = (size_t)b * S_ + ch * 128;
  const u16* proj = (const u16*)(p.ws + OFF_BIG);
  const float* nw = p.in[13] + layer * 256;
  const float* nb = p.in[14] + layer * 256;
  const int tw = (wid < 4) ? wid : 11 - wid;
  const int m = lane & 15, hh = lane >> 4;
  const u16* wrow = (const u16*)(p.ws + OFF_WSB) + ((size_t)(layer * 4 + g) * 128 + 16 * tw + m) * 128 + 8 * hh;
  const int nks = ((16 * tw + 15) >> 5) + 1;
  bf16x8 wfr[4];
#pragma unroll
  for (int ks = 0; ks < 4; ks++) { if (ks < nks) wfr[ks] = *(const bf16x8*)(wrow + 32 * ks); else wfr[ks] = (bf16x8){0, 0, 0, 0, 0, 0, 0, 0}; }
  for (int t4b = 0; t4b < 16; t4b += 4) {
    float v[4][4], mu[4], rs[4];
#pragma unroll
    for (int q = 0; q < 4; q++) {
      const int tl = wid * 16 + t4b + q;
      const uint2 raw = *(const uint2*)(proj + (tok0 + tl) * PW + 2584 + lane * 4);
      v[q][0] = gelu_t(lo2f(raw.x)); v[q][1] = gelu_t(hi2f(raw.x)); v[q][2] = gelu_t(lo2f(raw.y)); v[q][3] = gelu_t(hi2f(raw.y));
    }
#pragma unroll
    for (int q = 0; q < 4; q++) mu[q] = v[q][0] + v[q][1] + v[q][2] + v[q][3];
#pragma unroll
    for (int o = 32; o > 0; o >>= 1) {
#pragma unroll
      for (int q = 0; q < 4; q++) mu[q] += __shfl_xor(mu[q], o);
    }
#pragma unroll
    for (int q = 0; q < 4; q++) {
      mu[q] *= (1.f / 256.f);
      float d2 = 0.f;
#pragma unroll
      for (int j = 0; j < 4; j++) { v[q][j] -= mu[q]; d2 += v[q][j] * v[q][j]; }
      rs[q] = d2;
    }
#pragma unroll
    for (int o = 32; o > 0; o >>= 1) {
#pragma unroll
      for (int q = 0; q < 4; q++) rs[q] += __shfl_xor(rs[q], o);
    }
    if ((lane >> 4) == g) {
#pragma unroll
      for (int q = 0; q < 4; q++) {
        const int tl = wid * 16 + t4b + q;
        const float r = rsqrtf(rs[q] * (1.f / 256.f) + 1e-5f);
#pragma unroll
        for (int j = 0; j < 4; j++) { const int cch = lane * 4 + j; VnT[((lane & 15) * 4 + j) * KS + tl] = f2bf(v[q][j] * r * nw[cch] + nb[cch]); }
      }
    }
  }
  __syncthreads();
  f32x4 acc[4];
#pragma unroll
  for (int nt = 0; nt < 4; nt++) acc[nt] = (f32x4){0.f, 0.f, 0.f, 0.f};
#pragma unroll
  for (int ks = 0; ks < 4; ks++) {
    if (ks < nks) {
#pragma unroll
      for (int nt = 0; nt < 4; nt++) {
        const bf16x8 vfr = *(const bf16x8*)(VnT + (16 * nt + m) * KS + 32 * ks + 8 * hh);
        acc[nt] = mfma16(vfr, wfr[ks], acc[nt]);
      }
    }
  }
  {
    const int t_ = 16 * tw + m;
    const size_t tok = tok0 + t_;
    const float bsv = p.in[16][(size_t)(layer * 4 + g) * 128 + t_];
#pragma unroll
    for (int nt = 0; nt < 4; nt++) {
      const int c0 = 16 * nt + 4 * hh;
      const uint2 ur = *(const uint2*)(proj + tok * PW + 2328 + g * 64 + c0);
      const float u0 = gelu_t(lo2f(ur.x)), u1 = gelu_t(hi2f(ur.x)), u2 = gelu_t(lo2f(ur.y)), u3 = gelu_t(hi2f(ur.y));
      uint2 pk; pk.x = pack2(u0 * (acc[nt][0] + bsv), u1 * (acc[nt][1] + bsv)); pk.y = pack2(u2 * (acc[nt][2] + bsv), u3 * (acc[nt][3] + bsv));
      *(uint2*)((u16*)(p.ws + OFF_MIX) + tok * 1024 + 768 + g * 64 + c0) = pk;
    }
  }
  __syncthreads();
}

DI void qk_block(const u16* __restrict__ Kb, int ldk, bf16x8 q0, bf16x8 q1, f32x4 (&st)[4], int lane) {
  const int m = lane & 15, hh = lane >> 4;
#pragma unroll
  for (int i = 0; i < 4; i++) {
    const int key = 32 * (i >> 1) + 8 * (m >> 2) + 4 * (i & 1) + (m & 3);
    const u16* kp = Kb + (size_t)key * ldk + 8 * hh;
    const bf16x8 k0 = *(const bf16x8*)kp, k1 = *(const bf16x8*)(kp + 32);
    f32x4 z = {0.f, 0.f, 0.f, 0.f};
    z = mfma16(k0, q0, z);
    st[i] = mfma16(k1, q1, z);
  }
}
DI void pv_block(const u16* __restrict__ VTb, int ldv, bf16x8 p0, bf16x8 p1, f32x4 (&o)[4], int lane) {
  const int m = lane & 15, hh = lane >> 4;
#pragma unroll
  for (int mt = 0; mt < 4; mt++) {
    const u16* vp = VTb + (size_t)(mt * 16 + m) * ldv + 8 * hh;
    const bf16x8 v0 = *(const bf16x8*)vp, v1 = *(const bf16x8*)(vp + 32);
    o[mt] = mfma16(v0, p0, o[mt]);
    o[mt] = mfma16(v1, p1, o[mt]);
  }
}
DI bf16x8 packp(const f32x4& a, const f32x4& b) {
  typedef __attribute__((ext_vector_type(4))) unsigned u32x4_t;
  u32x4_t v = {pack2(a[0], a[1]), pack2(a[2], a[3]), pack2(b[0], b[1]), pack2(b[2], b[3])};
  return __builtin_bit_cast(bf16x8, v);
}
template <class MF>
DI void attn_block(const u16* Kb, int ldk, const u16* VTb, int ldv, bf16x8 q0, bf16x8 q1, float& m_run, float& l_run, f32x4 (&o)[4], MF mask, int lane) {
  f32x4 st[4];
  qk_block(Kb, ldk, q0, q1, st, lane);
  const int h = lane >> 4;
  float bm = NEGF;
#pragma unroll
  for (int i = 0; i < 4; i++)
#pragma unroll
    for (int r = 0; r < 4; r++) {
      const int kk = 32 * (i >> 1) + 8 * h + 4 * (i & 1) + r;
      const float v = mask(kk) ? st[i][r] : NEGF;
      st[i][r] = v; bm = fmaxf(bm, v);
    }
  bm = fmaxf(bm, __shfl_xor(bm, 16)); bm = fmaxf(bm, __shfl_xor(bm, 32));
  const float mn = fmaxf(m_run, bm);
  const float sc = __expf(m_run - mn);
  float ps = 0.f;
#pragma unroll
  for (int i = 0; i < 4; i++)
#pragma unroll
    for (int r = 0; r < 4; r++) {
      const float pv = (st[i][r] > -1e29f) ? __expf(st[i][r] - mn) : 0.f;
      st[i][r] = pv; ps += pv;
    }
  l_run = l_run * sc + ps; m_run = mn;
#pragma unroll
  for (int mt = 0; mt < 4; mt++) { o[mt][0] *= sc; o[mt][1] *= sc; o[mt][2] *= sc; o[mt][3] *= sc; }
  pv_block(VTb, ldv, packp(st[0], st[1]), packp(st[2], st[3]), o, lane);
}
DI unsigned long long rfl64(unsigned long long v) {
  unsigned lo = __builtin_amdgcn_readfirstlane((unsigned)v), hi = __builtin_amdgcn_readfirstlane((unsigned)(v >> 32));
  return ((unsigned long long)hi << 32) | lo;
}

DI void nsa_item(const P& p, int item, char* smem) {
  const int tid = tidx(), lane = tid & 63, wid = tid >> 6;
  const int bh = item & 7, qt = 255 - (item >> 3);
  const int b = bh >> 1, hk = bh & 1;
  const int t0 = qt * 32 + wid * 4;
  float* pg = (float*)smem + wid * (2048 + 128);
  float* impb = pg + 2048;
  const int col = lane & 15, h = lane >> 4, qi = col >> 2, g = col & 3;
  const int t = t0 + qi;
  const u16* proj = (const u16*)(p.ws + OFF_BIG);
  const size_t rowq = (size_t)(b * S_ + t) * PW;
  const bf16x8 q0 = *(const bf16x8*)(proj + rowq + 1024 + (hk * 4 + g) * 64 + 8 * h);
  const bf16x8 q1 = *(const bf16x8*)(proj + rowq + 1024 + (hk * 4 + g) * 64 + 32 + 8 * h);
  const float gt0 = sigm(bf2f(proj[rowq + 2304 + hk * 12 + g * 3 + 0]));
  const float gt1 = sigm(bf2f(proj[rowq + 2304 + hk * 12 + g * 3 + 1]));
  const float gt2 = sigm(bf2f(proj[rowq + 2304 + hk * 12 + g * 3 + 2]));
  f32x4 outa[4];
#pragma unroll
  for (int mt = 0; mt < 4; mt++) outa[mt] = (f32x4){0.f, 0.f, 0.f, 0.f};
  const int tb = t0 >> 6;

  for (int i = lane; i < 2048; i += 64) pg[i] = 0.f;
  const int nmaxw = (t0 + 3 >= 31) ? ((t0 + 3 - 31) >> 4) : -1;
  if (nmaxw >= 0) {
    const u16* kcb = (const u16*)(p.ws + OFF_KC) + (size_t)bh * 512 * 64;
    const u16* vcb = (const u16*)(p.ws + OFF_VCT) + (size_t)bh * 64 * 512;
    const int nblk = (nmaxw >> 6) + 1;
    const int nqv = (t >= 31) ? ((t - 31) >> 4) : -1;
    float m_run = NEGF, l_run = 0.f;
    for (int blk = 0; blk < nblk; blk++) {
      f32x4 st[4];
      qk_block(kcb + (size_t)blk * 64 * 64, 64, q0, q1, st, lane);
      float bm = NEGF;
#pragma unroll
      for (int i = 0; i < 4; i++)
#pragma unroll
        for (int r = 0; r < 4; r++) {
          const int n = blk * 64 + 32 * (i >> 1) + 8 * h + 4 * (i & 1) + r;
          const float v = (n <= nqv) ? st[i][r] : NEGF;
          st[i][r] = v; bm = fmaxf(bm, v);
        }
      bm = fmaxf(bm, __shfl_xor(bm, 16)); bm = fmaxf(bm, __shfl_xor(bm, 32));
      const float mn = fmaxf(m_run, bm);
      float ps = 0.f;
#pragma unroll
      for (int i = 0; i < 4; i++)
#pragma unroll
        for (int r = 0; r < 4; r++) ps += (st[i][r] > -1e29f) ? __expf(st[i][r] - mn) : 0.f;
      l_run = l_run * __expf(m_run - mn) + ps; m_run = mn;
    }
    float lt = l_run; lt += __shfl_xor(lt, 16); lt += __shfl_xor(lt, 32);
    const float inv = lt > 0.f ? 1.f / lt : 0.f;
    f32x4 o[4];
#pragma unroll
    for (int mt = 0; mt < 4; mt++) o[mt] = (f32x4){0.f, 0.f, 0.f, 0.f};
    for (int blk = 0; blk < nblk; blk++) {
      f32x4 st[4];
      qk_block(kcb + (size_t)blk * 64 * 64, 64, q0, q1, st, lane);
#pragma unroll
      for (int i = 0; i < 4; i++)
#pragma unroll
        for (int r = 0; r < 4; r++) {
          const int n = blk * 64 + 32 * (i >> 1) + 8 * h + 4 * (i & 1) + r;
          const float pv = (n <= nqv) ? __expf(st[i][r] - m_run) * inv : 0.f;
          st[i][r] = pv;
          float psum = pv; psum += __shfl_xor(psum, 1); psum += __shfl_xor(psum, 2);
          if (g == 0) pg[qi * 512 + n] = psum;
        }
      pv_block(vcb + blk * 64, 512, packp(st[0], st[1]), packp(st[2], st[3]), o, lane);
    }
#pragma unroll
    for (int mt = 0; mt < 4; mt++) { outa[mt][0] += gt0 * o[mt][0]; outa[mt][1] += gt0 * o[mt][1]; outa[mt][2] += gt0 * o[mt][2]; outa[mt][3] += gt0 * o[mt][3]; }
  }
  __builtin_amdgcn_fence(__ATOMIC_RELEASE, "wavefront");
  asm volatile("s_waitcnt lgkmcnt(0)" ::: "memory");

  unsigned long long mylo = 0, myhi = 0, ulo = 0, uhi = 0;
  if (tb <= 15) { mylo = (2ull << tb) - 1ull; ulo = mylo; }
  else {
    for (int qq = 0; qq < 4; qq++) {
      const float* pgq = pg + qq * 512;
      const int j0 = lane, j1 = lane + 64;
      const bool c0ok = (j0 >= 1 && j0 <= tb - 2), c1ok = (j1 <= tb - 2);
      float v0 = -1.f, v1 = -1.f;
      if (c0ok) v0 = pgq[4 * j0 - 1] + pgq[4 * j0] + pgq[4 * j0 + 1] + pgq[4 * j0 + 2] + pgq[4 * j0 + 3];
      if (c1ok) v1 = pgq[4 * j1 - 1] + pgq[4 * j1] + pgq[4 * j1 + 1] + pgq[4 * j1 + 2] + pgq[4 * j1 + 3];
      asm volatile("s_waitcnt lgkmcnt(0)" ::: "memory");
      impb[j0] = v0; impb[j1] = v1;
      asm volatile("s_waitcnt lgkmcnt(0)" ::: "memory");
      int c0 = 0, c1 = 0;
      for (int jj = 1; jj <= tb - 2; jj++) {
        const float vv = impb[jj];
        c0 += ((vv > v0) || (vv == v0 && jj < j0)) ? 1 : 0;
        c1 += ((vv > v1) || (vv == v1 && jj < j1)) ? 1 : 0;
      }
      const bool s0 = (c0ok && c0 < 13) || j0 == 0 || j0 == tb || j0 == tb - 1;
      const bool s1 = (c1ok && c1 < 13) || j1 == tb || j1 == tb - 1;
      const unsigned long long blo = __ballot(s0), bhi_ = __ballot(s1);
      if (qi == qq) { mylo = blo; myhi = bhi_; }
      ulo |= blo; uhi |= bhi_;
      asm volatile("s_waitcnt lgkmcnt(0)" ::: "memory");
    }
  }

  {
    const u16* ksb = proj + (size_t)b * S_ * PW + 1792 + hk * 64;
    const u16* vsb = (const u16*)(p.ws + OFF_VTS) + (size_t)bh * 64 * S_;
    float m_run = NEGF, l_run = 0.f;
    f32x4 o[4];
#pragma unroll
    for (int mt = 0; mt < 4; mt++) o[mt] = (f32x4){0.f, 0.f, 0.f, 0.f};
    for (int half = 0; half < 2; half++) {
      unsigned long long um = rfl64(half ? uhi : ulo);
      const unsigned long long mym = half ? myhi : mylo;
      while (um) {
        const int bl = __builtin_ctzll(um); um &= um - 1ull;
        const int blk = bl + half * 64;
        const bool selq = (mym >> bl) & 1ull;
        const int kbase = blk * 64;
        attn_block(ksb + (size_t)kbase * PW, PW, vsb + kbase, S_, q0, q1, m_run, l_run, o,
                   [&](int kk) { return selq && (kbase + kk <= t); }, lane);
      }
    }
    float lt = l_run; lt += __shfl_xor(lt, 16); lt += __shfl_xor(lt, 32);
    const float w = lt > 0.f ? gt1 / lt : 0.f;
#pragma unroll
    for (int mt = 0; mt < 4; mt++) { outa[mt][0] += w * o[mt][0]; outa[mt][1] += w * o[mt][1]; outa[mt][2] += w * o[mt][2]; outa[mt][3] += w * o[mt][3]; }
  }
  {
    const u16* kwb = proj + (size_t)b * S_ * PW + 2048 + hk * 64;
    const u16* vwb = (const u16*)(p.ws + OFF_VTW) + (size_t)bh * 64 * S_;
    float m_run = NEGF, l_run = 0.f;
    f32x4 o[4];
#pragma unroll
    for (int mt = 0; mt < 4; mt++) o[mt] = (f32x4){0.f, 0.f, 0.f, 0.f};
    const int wb0 = (t0 >= 511) ? ((t0 - 511) >> 6) : 0;
    for (int blk = wb0; blk <= tb; blk++) {
      const int kbase = blk * 64;
      attn_block(kwb + (size_t)kbase * PW, PW, vwb + kbase, S_, q0, q1, m_run, l_run, o,
                 [&](int kk) { const int kp = kbase + kk; return (kp <= t) && (kp > t - 512); }, lane);
    }
    float lt = l_run; lt += __shfl_xor(lt, 16); lt += __shfl_xor(lt, 32);
    const float w = lt > 0.f ? gt2 / lt : 0.f;
#pragma unroll
    for (int mt = 0; mt < 4; mt++) { outa[mt][0] += w * o[mt][0]; outa[mt][1] += w * o[mt][1]; outa[mt][2] += w * o[mt][2]; outa[mt][3] += w * o[mt][3]; }
  }
  u16* mo = (u16*)(p.ws + OFF_MIX) + (size_t)(b * S_ + t) * 1024 + 256 + (hk * 4 + g) * 64 + 4 * h;
#pragma unroll
  for (int mt = 0; mt < 4; mt++) {
    uint2 pk; pk.x = pack2(outa[mt][0], outa[mt][1]); pk.y = pack2(outa[mt][2], outa[mt][3]);
    *(uint2*)(mo + 16 * mt) = pk;
  }
  __syncthreads();
}


constexpr int KROW = 80;
constexpr int STG = 64 * KROW;
DI void qk_lds(const u16* Ks, bf16x8 q0, bf16x8 q1, f32x4 (&st)[4], int lane) {
  const u16* kp = Ks + (lane & 15) * KROW + 8 * (lane >> 4);
#pragma unroll
  for (int i = 0; i < 4; i++) {
    const bf16x8 k0 = *(const bf16x8*)(kp + i * 16 * KROW), k1 = *(const bf16x8*)(kp + i * 16 * KROW + 32);
    f32x4 z = {0.f, 0.f, 0.f, 0.f};
    z = mfma16(k0, q0, z);
    st[i] = mfma16(k1, q1, z);
  }
}
DI void pv_lds(const u16* Vs, bf16x8 p0, bf16x8 p1, f32x4 (&o)[4], int lane) {
  const u16* vp = Vs + (lane & 15) * KROW + 8 * (lane >> 4);
#pragma unroll
  for (int mt = 0; mt < 4; mt++) {
    const bf16x8 v0 = *(const bf16x8*)(vp + mt * 16 * KROW), v1 = *(const bf16x8*)(vp + mt * 16 * KROW + 32);
    o[mt] = mfma16(v0, p0, o[mt]);
    o[mt] = mfma16(v1, p1, o[mt]);
  }
}
constexpr float LOG2E = 1.4426950408889634f;
DI float xmax16(float v) { const unsigned u = __float_as_uint(v); auto r = __builtin_amdgcn_permlane16_swap(u, u, false, false); return fmaxf(__uint_as_float(r[0]), __uint_as_float(r[1])); }
DI float xmax32(float v) { const unsigned u = __float_as_uint(v); auto r = __builtin_amdgcn_permlane32_swap(u, u, false, false); return fmaxf(__uint_as_float(r[0]), __uint_as_float(r[1])); }
template <int MODE, class MF>
DI void attn_lds(const u16* Ks, const u16* Vs, bf16x8 q0, bf16x8 q1, float& m_run, float& l_run, f32x4 (&o)[4], MF mask, bool selq, int lane) {
  f32x4 st[4];
  bf16x8 kf[8], vf[8];
  {
    const u16* kp = Ks + (lane & 15) * KROW + 8 * (lane >> 4);
    const u16* vp = Vs + (lane & 15) * KROW + 8 * (lane >> 4);
#pragma unroll
    for (int i = 0; i < 4; i++) { kf[2 * i] = *(const bf16x8*)(kp + i * 16 * KROW); kf[2 * i + 1] = *(const bf16x8*)(kp + i * 16 * KROW + 32); }
#pragma unroll
    for (int i = 0; i < 4; i++) { vf[2 * i] = *(const bf16x8*)(vp + i * 16 * KROW); vf[2 * i + 1] = *(const bf16x8*)(vp + i * 16 * KROW + 32); }
  }
  __builtin_amdgcn_sched_barrier(0);
#pragma unroll
  for (int i = 0; i < 4; i++) {
    f32x4 z = {0.f, 0.f, 0.f, 0.f};
    z = mfma16(kf[2 * i], q0, z);
    st[i] = mfma16(kf[2 * i + 1], q1, z);
  }
  const int h = lane >> 4;
  float bm = NEGF;
#pragma unroll
  for (int i = 0; i < 4; i++)
#pragma unroll
    for (int r = 0; r < 4; r++) {
      if (MODE == 2) {
        const int kk = 32 * (i >> 1) + 8 * h + 4 * (i & 1) + r;
        st[i][r] = mask(kk) ? st[i][r] : NEGF;
      }
      bm = fmaxf(bm, st[i][r]);
    }
  if (MODE == 1) bm = selq ? bm : NEGF;
  bm = xmax32(xmax16(bm));
  const float mn = fmaxf(m_run, bm);
  const float sc = __builtin_amdgcn_exp2f((m_run - mn) * LOG2E);
  float mns = fmaxf(mn, -1e20f) * LOG2E;
  if (MODE == 1) mns = selq ? mns : 1e30f;
  float ps = 0.f;
#pragma unroll
  for (int i = 0; i < 4; i++)
#pragma unroll
    for (int r = 0; r < 4; r++) {
      const float pv = __builtin_amdgcn_exp2f(fmaf(st[i][r], LOG2E, -mns));
      st[i][r] = pv; ps += pv;
    }
  l_run = l_run * sc + ps; m_run = mn;
#pragma unroll
  for (int mt = 0; mt < 4; mt++) { o[mt][0] *= sc; o[mt][1] *= sc; o[mt][2] *= sc; o[mt][3] *= sc; }
  const bf16x8 p0 = packp(st[0], st[1]), p1 = packp(st[2], st[3]);
#pragma unroll
  for (int mt = 0; mt < 4; mt++) {
    o[mt] = mfma16(vf[2 * mt], p0, o[mt]);
    o[mt] = mfma16(vf[2 * mt + 1], p1, o[mt]);
  }
}

DI void nsa_item2(const P& p, int item, char* smem) {
  const int tid = tidx(), lane = tid & 63, wid = tid >> 6;
  const int bh = item & 7, qt = 255 - (item >> 3);
  const int b = bh >> 1, hk = bh & 1;
  const int t0 = qt * 32 + wid * 4;
  u16* stg = (u16*)smem;
  float* impw = (float*)(smem + 2 * 2 * 2 * STG * 2) + wid * 1024;
  const int col = lane & 15, h = lane >> 4, qi = col >> 2, g = col & 3;
  const int t = t0 + qi;
  const u16* proj = (const u16*)(p.ws + OFF_BIG);
  const size_t rowq = (size_t)(b * S_ + t) * PW;
  const bf16x8 q0 = *(const bf16x8*)(proj + rowq + 1024 + (hk * 4 + g) * 64 + 8 * h);
  const bf16x8 q1 = *(const bf16x8*)(proj + rowq + 1024 + (hk * 4 + g) * 64 + 32 + 8 * h);
  const float gt0 = sigm(bf2f(proj[rowq + 2304 + hk * 12 + g * 3 + 0]));
  const float gt1 = sigm(bf2f(proj[rowq + 2304 + hk * 12 + g * 3 + 1]));
  const float gt2 = sigm(bf2f(proj[rowq + 2304 + hk * 12 + g * 3 + 2]));
  f32x4 outa[4], o[4];
#pragma unroll
  for (int mt = 0; mt < 4; mt++) { outa[mt] = (f32x4){0.f, 0.f, 0.f, 0.f}; o[mt] = (f32x4){0.f, 0.f, 0.f, 0.f}; }
  const int tb = qt >> 1;
  const int nc = (qt >> 5) + 1;
  const int wb0 = (qt * 32 >= 511) ? ((qt * 32 - 511) >> 6) : 0;
  const int nw = tb - wb0 + 1;
  const int U = 2 * nc + nw + tb + 1;
  const int nqv = (t >= 31) ? ((t - 31) >> 4) : -1;
  const u16* kcb = (const u16*)(p.ws + OFF_KC) + (size_t)bh * 512 * 64;
  const u16* vcb = (const u16*)(p.ws + OFF_VCT) + (size_t)bh * 64 * 512;
  const u16* ksb = proj + (size_t)b * S_ * PW + 1792 + hk * 64;
  const u16* vsb = (const u16*)(p.ws + OFF_VTS) + (size_t)bh * 64 * S_;
  const u16* kwb = proj + (size_t)b * S_ * PW + 2048 + hk * 64;
  const u16* vwb = (const u16*)(p.ws + OFF_VTW) + (size_t)bh * 64 * S_;
  const int srow = tid >> 3, sch = (tid & 7) * 8;
  const int klr = 16 * (2 * (srow >> 5) + ((srow >> 2) & 1)) + 4 * ((srow >> 3) & 3) + (srow & 3);
  const int koff = klr * KROW + sch, voff = srow * KROW + sch;
  uint4 rk0 = make_uint4(0,0,0,0), rk1 = rk0, rv0 = rk0, rv1 = rk0;
#define LDBLK(u_, rk_, rv_) do { const int uu_ = (u_); const u16 *kp_, *vp_; \
    if (uu_ < 2 * nc) { const int bl_ = (uu_ < nc) ? uu_ : uu_ - nc; kp_ = kcb + (size_t)(bl_ * 64 + srow) * 64 + sch; vp_ = vcb + (size_t)srow * 512 + bl_ * 64 + sch; } \
    else if (uu_ < 2 * nc + nw) { const int bl_ = wb0 + (uu_ - 2 * nc); kp_ = kwb + (size_t)(bl_ * 64 + srow) * PW + sch; vp_ = vwb + (size_t)srow * S_ + bl_ * 64 + sch; } \
    else { const int bl_ = uu_ - 2 * nc - nw; kp_ = ksb + (size_t)(bl_ * 64 + srow) * PW + sch; vp_ = vsb + (size_t)srow * S_ + bl_ * 64 + sch; } \
    rk_ = *(const uint4*)kp_; rv_ = *(const uint4*)vp_; } while (0)
  const int nst = (U + 1) >> 1;
  LDBLK(0, rk0, rv0);
  if (1 < U) LDBLK(1, rk1, rv1);
  *(uint4*)(stg + koff) = rk0; *(uint4*)(stg + STG + voff) = rv0;
  *(uint4*)(stg + 2 * STG + koff) = rk1; *(uint4*)(stg + 3 * STG + voff) = rv1;
  __syncthreads();
  float m_run = NEGF, l_run = 0.f, inv = 0.f;
  unsigned long long mylo = 0, myhi = 0, ulo = 0, uhi = 0;
  for (int s = 0; s < nst; s++) {
    if (s + 1 < nst) {
      LDBLK(2 * s + 2, rk0, rv0);
      if (2 * s + 3 < U) LDBLK(2 * s + 3, rk1, rv1);
    }
    const u16* sb = stg + (s & 1) * 4 * STG;
#pragma unroll
    for (int half = 0; half < 2; half++) {
      const int u = 2 * s + half;
      if (u >= U) break;
      const u16* Ks = sb + half * 2 * STG;
      const u16* Vs = Ks + STG;
      if (u < nc) {
        f32x4 st[4];
        qk_lds(Ks, q0, q1, st, lane);
        float bm = NEGF;
#pragma unroll
        for (int i = 0; i < 4; i++)
#pragma unroll
          for (int r = 0; r < 4; r++) {
            const int n = u * 64 + 32 * (i >> 1) + 8 * h + 4 * (i & 1) + r;
            const float v = (n <= nqv) ? st[i][r] : NEGF;
            st[i][r] = v; bm = fmaxf(bm, v);
          }
        bm = fmaxf(bm, __shfl_xor(bm, 16)); bm = fmaxf(bm, __shfl_xor(bm, 32));
        const float mn = fmaxf(m_run, bm);
        float ps = 0.f;
#pragma unroll
        for (int i = 0; i < 4; i++)
#pragma unroll
          for (int r = 0; r < 4; r++) ps += (st[i][r] > -1e29f) ? __expf(st[i][r] - mn) : 0.f;
        l_run = l_run * __expf(m_run - mn) + ps; m_run = mn;
        if (u == nc - 1) {
          float lt = l_run; lt += __shfl_xor(lt, 16); lt += __shfl_xor(lt, 32);
          inv = lt > 0.f ? 1.f / lt : 0.f;
        }
      } else if (u < 2 * nc) {
        const int blk = u - nc;
        f32x4 st[4];
        qk_lds(Ks, q0, q1, st, lane);
#pragma unroll
        for (int i = 0; i < 4; i++) {
          float a4 = 0.f, b3 = 0.f;
#pragma unroll
          for (int r = 0; r < 4; r++) {
            const int n = blk * 64 + 32 * (i >> 1) + 8 * h + 4 * (i & 1) + r;
            const float pv = (n <= nqv) ? __expf(st[i][r] - m_run) * inv : 0.f;
            st[i][r] = pv; a4 += pv; if (r == 3) b3 = pv;
          }
          a4 += __shfl_xor(a4, 1); a4 += __shfl_xor(a4, 2);
          b3 += __shfl_xor(b3, 1); b3 += __shfl_xor(b3, 2);
          if (g == 0) {
            const int j = blk * 16 + 8 * (i >> 1) + 2 * h + (i & 1);
            *(float2*)(impw + (qi * 128 + j) * 2) = make_float2(a4, b3);
          }
        }
        pv_lds(Vs, packp(st[0], st[1]), packp(st[2], st[3]), o, lane);
        if (u == 2 * nc - 1) {
#pragma unroll
          for (int mt = 0; mt < 4; mt++) {
            outa[mt][0] += gt0 * o[mt][0]; outa[mt][1] += gt0 * o[mt][1]; outa[mt][2] += gt0 * o[mt][2]; outa[mt][3] += gt0 * o[mt][3];
            o[mt] = (f32x4){0.f, 0.f, 0.f, 0.f};
          }
          m_run = NEGF; l_run = 0.f;
          asm volatile("s_waitcnt lgkmcnt(0)" ::: "memory");
          if (tb <= 15) { mylo = (2ull << tb) - 1ull; ulo = mylo; }
          else {
            for (int qq = 0; qq < 4; qq++) {
              const float* iw = impw + qq * 256;
              const int j0 = lane, j1 = lane + 64;
              const bool c0ok = (j0 >= 1 && j0 <= tb - 2), c1ok = (j1 <= tb - 2);
              unsigned k0 = 0, k1 = 0;
              if (c0ok) k0 = __float_as_uint(iw[2 * j0] + iw[2 * j0 - 1]) + 1u;
              if (c1ok) k1 = __float_as_uint(iw[2 * j1] + iw[2 * j1 - 1]) + 1u;
              unsigned thr = 0;
              for (int bit = 30; bit >= 0; bit--) {
                const unsigned trial = thr | (1u << bit);
                const int cnt = __popcll(__ballot(k0 >= trial)) + __popcll(__ballot(k1 >= trial));
                if (cnt >= 13) thr = trial;
              }
              const unsigned long long glo = __ballot(k0 > thr), ghi = __ballot(k1 > thr);
              const unsigned long long elo = __ballot(k0 == thr), ehi = __ballot(k1 == thr);
              const int need = 13 - __popcll(glo) - __popcll(ghi);
              const unsigned long long ltm = (1ull << lane) - 1ull;
              const int pre0 = __popcll(elo & ltm), pre1 = __popcll(elo) + __popcll(ehi & ltm);
              const bool s0 = (k0 > thr) || (k0 == thr && pre0 < need) || j0 == 0 || j0 == tb || j0 == tb - 1;
              const bool s1 = (k1 > thr) || (k1 == thr && pre1 < need) || j1 == tb || j1 == tb - 1;
              const unsigned long long blo = __ballot(s0), bhi_ = __ballot(s1);
              if (qi == qq) { mylo = blo; myhi = bhi_; }
              ulo |= blo; uhi |= bhi_;
            }
          }
        }
      } else if (u < 2 * nc + nw) {
        const int kbase = (wb0 + (u - 2 * nc)) * 64;
        if (kbase + 63 <= t0 && kbase > t0 + 3 - 512) attn_lds<0>(Ks, Vs, q0, q1, m_run, l_run, o, [&](int kk) { return true; }, true, lane);
        else attn_lds<2>(Ks, Vs, q0, q1, m_run, l_run, o, [&](int kk) { const int kp = kbase + kk; return (kp <= t) && (kp > t - 512); }, true, lane);
        if (u == 2 * nc + nw - 1) {
          float lt = l_run; lt += __shfl_xor(lt, 16); lt += __shfl_xor(lt, 32);
          const float w = lt > 0.f ? gt2 / lt : 0.f;
#pragma unroll
          for (int mt = 0; mt < 4; mt++) {
            outa[mt][0] += w * o[mt][0]; outa[mt][1] += w * o[mt][1]; outa[mt][2] += w * o[mt][2]; outa[mt][3] += w * o[mt][3];
            o[mt] = (f32x4){0.f, 0.f, 0.f, 0.f};
          }
          m_run = NEGF; l_run = 0.f;
        }
      } else {
        const int blk = u - 2 * nc - nw;
        const unsigned long long um = rfl64(blk < 64 ? ulo : uhi);
        if ((um >> (blk & 63)) & 1ull) {
          const bool selq = ((blk < 64 ? mylo : myhi) >> (blk & 63)) & 1ull;
          const int kbase = blk * 64;
          if (blk < tb) attn_lds<1>(Ks, Vs, q0, q1, m_run, l_run, o, [&](int kk) { return true; }, selq, lane);
          else attn_lds<2>(Ks, Vs, q0, q1, m_run, l_run, o, [&](int kk) { return selq && (kbase + kk <= t); }, selq, lane);
        }
      }
    }
    if (s + 1 < nst) {
      u16* db = stg + ((s + 1) & 1) * 4 * STG;
      *(uint4*)(db + koff) = rk0; *(uint4*)(db + STG + voff) = rv0;
      *(uint4*)(db + 2 * STG + koff) = rk1; *(uint4*)(db + 3 * STG + voff) = rv1;
    }
    __syncthreads();
  }
#undef LDBLK
  {
    float lt = l_run; lt += __shfl_xor(lt, 16); lt += __shfl_xor(lt, 32);
    const float w = lt > 0.f ? gt1 / lt : 0.f;
#pragma unroll
    for (int mt = 0; mt < 4; mt++) { outa[mt][0] += w * o[mt][0]; outa[mt][1] += w * o[mt][1]; outa[mt][2] += w * o[mt][2]; outa[mt][3] += w * o[mt][3]; }
  }
  u16* mo = (u16*)(p.ws + OFF_MIX) + (size_t)(b * S_ + t) * 1024 + 256 + (hk * 4 + g) * 64 + 4 * h;
#pragma unroll
  for (int mt = 0; mt < 4; mt++) {
    uint2 pk; pk.x = pack2(outa[mt][0], outa[mt][1]); pk.y = pack2(outa[mt][2], outa[mt][3]);
    *(uint2*)(mo + 16 * mt) = pk;
  }
}


DI void load_frags(const u16* Ks, const u16* Vs, bf16x8 (&kf)[8], bf16x8 (&vf)[8], int lane) {
  const u16* kp = Ks + (lane & 15) * KROW + 8 * (lane >> 4);
  const u16* vp = Vs + (lane & 15) * KROW + 8 * (lane >> 4);
#pragma unroll
  for (int i = 0; i < 4; i++) { kf[2 * i] = *(const bf16x8*)(kp + i * 16 * KROW); kf[2 * i + 1] = *(const bf16x8*)(kp + i * 16 * KROW + 32); }
#pragma unroll
  for (int i = 0; i < 4; i++) { vf[2 * i] = *(const bf16x8*)(vp + i * 16 * KROW); vf[2 * i + 1] = *(const bf16x8*)(vp + i * 16 * KROW + 32); }
}
template <int MODE, class MF>
DI void attn_core(const bf16x8 (&kf)[8], const bf16x8 (&vf)[8], bf16x8 q0, bf16x8 q1, float& m_run, float& l_run, f32x4 (&o)[4], MF mask, bool selq, int lane) {
  f32x4 st[4];
#pragma unroll
  for (int i = 0; i < 4; i++) {
    f32x4 z = {0.f, 0.f, 0.f, 0.f};
    z = mfma16(kf[2 * i], q0, z);
    st[i] = mfma16(kf[2 * i + 1], q1, z);
  }
  const int h = lane >> 4;
  float bm = NEGF;
#pragma unroll
  for (int i = 0; i < 4; i++)
#pragma unroll
    for (int r = 0; r < 4; r++) {
      if (MODE == 2) {
        const int kk = 32 * (i >> 1) + 8 * h + 4 * (i & 1) + r;
        st[i][r] = mask(kk) ? st[i][r] : NEGF;
      }
      bm = fmaxf(bm, st[i][r]);
    }
  if (MODE == 1) bm = selq ? bm : NEGF;
  bm = xmax32(xmax16(bm));
  const float mn = fmaxf(m_run, bm);
  const float sc = __builtin_amdgcn_exp2f((m_run - mn) * LOG2E);
  float mns = fmaxf(mn, -1e20f) * LOG2E;
  if (MODE == 1) mns = selq ? mns : 1e30f;
  float ps = 0.f;
#pragma unroll
  for (int i = 0; i < 4; i++)
#pragma unroll
    for (int r = 0; r < 4; r++) {
      const float pv = __builtin_amdgcn_exp2f(fmaf(st[i][r], LOG2E, -mns));
      st[i][r] = pv; ps += pv;
    }
  l_run = l_run * sc + ps; m_run = mn;
#pragma unroll
  for (int mt = 0; mt < 4; mt++) { o[mt][0] *= sc; o[mt][1] *= sc; o[mt][2] *= sc; o[mt][3] *= sc; }
  const bf16x8 p0 = packp(st[0], st[1]), p1 = packp(st[2], st[3]);
#pragma unroll
  for (int mt = 0; mt < 4; mt++) {
    o[mt] = mfma16(vf[2 * mt], p0, o[mt]);
    o[mt] = mfma16(vf[2 * mt + 1], p1, o[mt]);
  }
}


DI void load_k(const u16* Ks, bf16x8 (&kf)[8], int lane) {
  const u16* kp = Ks + (lane & 15) * KROW + 8 * (lane >> 4);
#pragma unroll
  for (int i = 0; i < 4; i++) { kf[2 * i] = *(const bf16x8*)(kp + i * 16 * KROW); kf[2 * i + 1] = *(const bf16x8*)(kp + i * 16 * KROW + 32); }
}
template <class MF>
DI void qk_part(const bf16x8 (&kf)[8], bf16x8 q0, bf16x8 q1, f32x4 (&st)[4], bool domask, MF mask, int lane) {
#pragma unroll
  for (int i = 0; i < 4; i++) {
    f32x4 z = {0.f, 0.f, 0.f, 0.f};
    z = mfma16(kf[2 * i], q0, z);
    st[i] = mfma16(kf[2 * i + 1], q1, z);
  }
  if (domask) {
#pragma unroll
    for (int i = 0; i < 4; i++)
#pragma unroll
      for (int r = 0; r < 4; r++) {
        const int cc = 32 * (i >> 1) + 4 * (i & 1) + r;
        st[i][r] = mask(cc) ? st[i][r] : NEGF;
      }
  }
}
DI void sm_pv_part(f32x4 (&st)[4], const bf16x8 (&vf)[8], float& m_run, float& l_run, f32x4 (&o)[4], bool selq, int lane) {
  float bm = NEGF;
#pragma unroll
  for (int i = 0; i < 4; i++)
#pragma unroll
    for (int r = 0; r < 4; r++) bm = fmaxf(bm, st[i][r]);
  bm = selq ? bm : NEGF;
  bm = xmax32(xmax16(bm));
  if (!__all(bm - m_run <= 8.f)) {
    const float mn = fmaxf(m_run, bm);
    const float sc = __builtin_amdgcn_exp2f((m_run - mn) * LOG2E);
    l_run *= sc; m_run = mn;
#pragma unroll
    for (int mt = 0; mt < 4; mt++) { o[mt][0] *= sc; o[mt][1] *= sc; o[mt][2] *= sc; o[mt][3] *= sc; }
  }
  float mns = fmaxf(m_run, -1e20f) * LOG2E;
  mns = selq ? mns : 1e30f;
  float ps = 0.f;
#pragma unroll
  for (int i = 0; i < 4; i++)
#pragma unroll
    for (int r = 0; r < 4; r++) {
      const float pv = __builtin_amdgcn_exp2f(fmaf(st[i][r], LOG2E, -mns));
      st[i][r] = pv; ps += pv;
    }
  l_run += ps;
  const bf16x8 p0 = packp(st[0], st[1]), p1 = packp(st[2], st[3]);
#pragma unroll
  for (int mt = 0; mt < 4; mt++) {
    o[mt] = mfma16(vf[2 * mt], p0, o[mt]);
    o[mt] = mfma16(vf[2 * mt + 1], p1, o[mt]);
  }
}

constexpr int NSA3_SMEM = 8 * STG * 2 + 8 * 8192;

DI void nsa_item3(const P& p, int item, char* smem) {
  const int tid = tidx(), lane = tid & 63, wid = __builtin_amdgcn_readfirstlane(tid >> 6);
  const int bh = item & 7, qt = 127 - (item >> 3);
  const int b = bh >> 1, hk = bh & 1;
  const int t0w = qt * 64 + wid * 8;
  u16* stg = (u16*)smem;
  float* impw = (float*)(smem + 8 * STG * 2) + wid * 2048;
  const int col = lane & 15, h = lane >> 4, qi = col >> 2, g = col & 3;
  const u16* proj = (const u16*)(p.ws + OFF_BIG);
  const int tqb = t0w + qi;
  bf16x8 q0[2], q1[2];
  float m_run[2], l_run[2], inv[2];
  f32x4 o[2][4];
  unsigned long long mylo[2], myhi[2], ulo[2], uhi[2];
#pragma unroll
  for (int c = 0; c < 2; c++) {
    const size_t rowq = (size_t)(b * S_ + tqb + 4 * c) * PW;
    q0[c] = *(const bf16x8*)(proj + rowq + 1024 + (hk * 4 + g) * 64 + 8 * h);
    q1[c] = *(const bf16x8*)(proj + rowq + 1024 + (hk * 4 + g) * 64 + 32 + 8 * h);
    m_run[c] = NEGF; l_run[c] = 0.f; inv[c] = 0.f;
    mylo[c] = 0; myhi[c] = 0; ulo[c] = 0; uhi[c] = 0;
#pragma unroll
    for (int mt = 0; mt < 4; mt++) o[c][mt] = (f32x4){0.f, 0.f, 0.f, 0.f};
  }
  const int tb = qt;
  const int nc = (qt >> 4) + 1;
  const int wb0 = (qt >= 8) ? (qt - 8) : 0;
  const int nw = tb - wb0 + 1;
  const int U = 2 * nc + nw + tb + 1;
  const u16* kcb = (const u16*)(p.ws + OFF_KC) + (size_t)bh * 512 * 64;
  const u16* vcb = (const u16*)(p.ws + OFF_VCT) + (size_t)bh * 64 * 512;
  const u16* ksb = proj + (size_t)b * S_ * PW + 1792 + hk * 64;
  const u16* vsb = (const u16*)(p.ws + OFF_VTS) + (size_t)bh * 64 * S_;
  const u16* kwb = proj + (size_t)b * S_ * PW + 2048 + hk * 64;
  const u16* vwb = (const u16*)(p.ws + OFF_VTW) + (size_t)bh * 64 * S_;
  const int srow = tid >> 3, sch = (tid & 7) * 8;
  const int klr = 16 * (2 * (srow >> 5) + ((srow >> 2) & 1)) + 4 * ((srow >> 3) & 3) + (srow & 3);
  const int koff = klr * KROW + sch, voff = srow * KROW + sch;
  uint4 rk0 = make_uint4(0, 0, 0, 0), rk1 = rk0, rv0 = rk0, rv1 = rk0;
#define LDBLK(u_, rk_, rv_) do { const int uu_ = (u_); const u16 *kp_, *vp_; int sr_ = srow; asm volatile("" : "+v"(sr_)); \
    if (uu_ < 2 * nc) { const int bl_ = (uu_ < nc) ? uu_ : uu_ - nc; kp_ = kcb + (unsigned)((bl_ * 64 + sr_) * 64 + sch); vp_ = vcb + (unsigned)(sr_ * 512 + bl_ * 64 + sch); } \
    else if (uu_ < 2 * nc + nw) { const int bl_ = wb0 + (uu_ - 2 * nc); kp_ = kwb + (unsigned)((bl_ * 64 + sr_) * PW + sch); vp_ = vwb + (unsigned)(sr_ * S_ + bl_ * 64 + sch); } \
    else { const int bl_ = uu_ - 2 * nc - nw; kp_ = ksb + (unsigned)((bl_ * 64 + sr_) * PW + sch); vp_ = vsb + (unsigned)(sr_ * S_ + bl_ * 64 + sch); } \
    rk_ = *(const uint4*)kp_; rv_ = *(const uint4*)vp_; } while (0)
#define EMIT_GATE(c_, gidx_, lt_) \
    int tql_ = tqb + 4 * (c_); asm volatile("" : "+v"(tql_)); \
    const float gate_ = sigm(bf2f(proj[(size_t)(b * S_ + tql_) * PW + 2304 + hk * 12 + g * 3 + (gidx_)])); \
    const float w_ = (lt_) > 0.f ? gate_ / (lt_) : 0.f; \
    float4* ps_ = (float4*)impw + ((c_) * 4) * 64 + lane;
#define EMIT_LDS(c_, gidx_, lt_, first_) do { EMIT_GATE(c_, gidx_, lt_) \
    _Pragma("unroll") for (int mt = 0; mt < 4; mt++) { \
      float4 a_ = make_float4(w_ * o[c_][mt][0], w_ * o[c_][mt][1], w_ * o[c_][mt][2], w_ * o[c_][mt][3]); \
      if (!(first_)) { const float4 pr_ = ps_[mt * 64]; a_.x += pr_.x; a_.y += pr_.y; a_.z += pr_.z; a_.w += pr_.w; } \
      ps_[mt * 64] = a_; \
      o[c_][mt] = (f32x4){0.f, 0.f, 0.f, 0.f}; } \
    m_run[c_] = NEGF; l_run[c_] = 0.f; } while (0)
#define EMIT_FINAL(c_, gidx_, lt_) do { EMIT_GATE(c_, gidx_, lt_) \
    u16* mo_ = (u16*)(p.ws + OFF_MIX) + (size_t)(b * S_ + tql_) * 1024 + 256 + (hk * 4 + g) * 64 + 4 * h; \
    _Pragma("unroll") for (int mt = 0; mt < 4; mt++) { \
      const float4 pr_ = ps_[mt * 64]; \
      uint2 pk_; pk_.x = pack2(pr_.x + w_ * o[c_][mt][0], pr_.y + w_ * o[c_][mt][1]); pk_.y = pack2(pr_.z + w_ * o[c_][mt][2], pr_.w + w_ * o[c_][mt][3]); \
      *(uint2*)(mo_ + 16 * mt) = pk_; } } while (0)
  const int nst = (U + 1) >> 1;
  LDBLK(0, rk0, rv0);
  if (1 < U) LDBLK(1, rk1, rv1);
  *(uint4*)(stg + koff) = rk0; *(uint4*)(stg + STG + voff) = rv0;
  *(uint4*)(stg + 2 * STG + koff) = rk1; *(uint4*)(stg + 3 * STG + voff) = rv1;
  __syncthreads();
  for (int s = 0; s < nst; s++) {
    if (s + 1 < nst) {
      LDBLK(2 * s + 2, rk0, rv0);
      if (2 * s + 3 < U) LDBLK(2 * s + 3, rk1, rv1);
    }
    const u16* sb = stg + (s & 1) * 4 * STG;
#pragma unroll 1
    for (int half = 0; half < 2; half++) {
      const int u = 2 * s + half;
      if (u >= U) break;
      const u16* Ks = sb + half * 2 * STG;
      const u16* Vs = Ks + STG;
      if (u < nc) {
        bf16x8 kf[8];
        load_k(Ks, kf, lane);
#pragma unroll
        for (int c = 0; c < 2; c++) {
          f32x4 st[4];
          int nlim = ((tqb + 4 * c - 31) >> 4) - u * 64 - 8 * h; asm volatile("" : "+v"(nlim));
          qk_part(kf, q0[c], q1[c], st, true, [&](int cc) { return cc <= nlim; }, lane);
          float bm = NEGF;
#pragma unroll
          for (int i = 0; i < 4; i++)
#pragma unroll
            for (int r = 0; r < 4; r++) bm = fmaxf(bm, st[i][r]);
          bm = xmax32(xmax16(bm));
          const float mn = fmaxf(m_run[c], bm);
          const float mns = fmaxf(mn, -1e20f) * LOG2E;
          float ps = 0.f;
#pragma unroll
          for (int i = 0; i < 4; i++)
#pragma unroll
            for (int r = 0; r < 4; r++) ps += __builtin_amdgcn_exp2f(fmaf(st[i][r], LOG2E, -mns));
          l_run[c] = l_run[c] * __builtin_amdgcn_exp2f((m_run[c] - mn) * LOG2E) + ps; m_run[c] = mn;
          if (u == nc - 1) {
            float lt = l_run[c]; lt += __shfl_xor(lt, 16); lt += __shfl_xor(lt, 32);
            inv[c] = lt > 0.f ? 1.f / lt : 0.f;
          }
        }
      } else if (u < 2 * nc) {
        const int blk = u - nc;
        bf16x8 kf[8];
        load_k(Ks, kf, lane);
        f32x4 st0[4], st1[4];
        { int nlim = ((tqb - 31) >> 4) - blk * 64 - 8 * h; asm volatile("" : "+v"(nlim)); qk_part(kf, q0[0], q1[0], st0, true, [&](int cc) { return cc <= nlim; }, lane); }
        { int nlim = ((tqb + 4 - 31) >> 4) - blk * 64 - 8 * h; asm volatile("" : "+v"(nlim)); qk_part(kf, q0[1], q1[1], st1, true, [&](int cc) { return cc <= nlim; }, lane); }
        bf16x8 vf[8];
        load_k(Vs, vf, lane);
#pragma unroll
        for (int c = 0; c < 2; c++) {
          f32x4 (&st)[4] = c == 0 ? st0 : st1;
          const float mns = fmaxf(m_run[c], -1e20f) * LOG2E;
          const float iv = inv[c];
#pragma unroll
          for (int i = 0; i < 4; i++) {
            float a4 = 0.f, b3 = 0.f;
#pragma unroll
            for (int r = 0; r < 4; r++) {
              const float pv = __builtin_amdgcn_exp2f(fmaf(st[i][r], LOG2E, -mns)) * iv;
              st[i][r] = pv; a4 += pv; if (r == 3) b3 = pv;
            }
            a4 += __shfl_xor(a4, 1); a4 += __shfl_xor(a4, 2);
            b3 += __shfl_xor(b3, 1); b3 += __shfl_xor(b3, 2);
            if (g == 0) {
              const int j = blk * 16 + 8 * (i >> 1) + 2 * h + (i & 1);
              *(float2*)(impw + ((c * 4 + qi) * 128 + j) * 2) = make_float2(a4, b3);
            }
          }
          const bf16x8 p0 = packp(st[0], st[1]), p1 = packp(st[2], st[3]);
#pragma unroll
          for (int mt = 0; mt < 4; mt++) {
            o[c][mt] = mfma16(vf[2 * mt], p0, o[c][mt]);
            o[c][mt] = mfma16(vf[2 * mt + 1], p1, o[c][mt]);
          }
        }
        if (u == 2 * nc - 1) {
          asm volatile("s_waitcnt lgkmcnt(0)" ::: "memory");
          if (tb <= 15) { mylo[0] = mylo[1] = (2ull << tb) - 1ull; ulo[0] = ulo[1] = mylo[0]; }
          else {
            for (int qq = 0; qq < 8; qq++) {
              const float* iw = impw + qq * 256;
              const int j0 = lane, j1 = lane + 64;
              const bool c0ok = (j0 >= 1 && j0 <= tb - 2), c1ok = (j1 <= tb - 2);
              unsigned k0 = 0, k1 = 0;
              if (c0ok) k0 = __float_as_uint(iw[2 * j0] + iw[2 * j0 - 1]) + 1u;
              if (c1ok) k1 = __float_as_uint(iw[2 * j1] + iw[2 * j1 - 1]) + 1u;
              unsigned thr = 0;
              for (int bit = 30; bit >= 0; bit--) {
                const unsigned trial = thr | (1u << bit);
                const int cnt = __popcll(__ballot(k0 >= trial)) + __popcll(__ballot(k1 >= trial));
                if (cnt >= 13) thr = trial;
              }
              const unsigned long long glo = __ballot(k0 > thr), ghi = __ballot(k1 > thr);
              const unsigned long long elo = __ballot(k0 == thr), ehi = __ballot(k1 == thr);
              const int need = 13 - __popcll(glo) - __popcll(ghi);
              int ln_ = lane; asm volatile("" : "+v"(ln_));
              const unsigned long long ltm = (1ull << ln_) - 1ull;
              const int pre0 = __popcll(elo & ltm), pre1 = __popcll(elo) + __popcll(ehi & ltm);
              const bool s0 = (k0 > thr) || (k0 == thr && pre0 < need) || j0 == 0 || j0 == tb || j0 == tb - 1;
              const bool s1 = (k1 > thr) || (k1 == thr && pre1 < need) || j1 == tb || j1 == tb - 1;
              const unsigned long long blo = __ballot(s0), bhi_ = __ballot(s1);
#pragma unroll
              for (int c = 0; c < 2; c++) {
                if ((qq >> 2) == c) {
                  if (qi == (qq & 3)) { mylo[c] = blo; myhi[c] = bhi_; }
                  ulo[c] |= blo; uhi[c] |= bhi_;
                }
              }
            }
          }
                  asm volatile("s_waitcnt lgkmcnt(0)" ::: "memory");
#pragma unroll
          for (int c = 0; c < 2; c++) EMIT_LDS(c, 0, 1.f, true);
        }
      } else if (u < 2 * nc + nw) {
        const int kbase = (wb0 + (u - 2 * nc)) * 64;
        bf16x8 kf[8];
        load_k(Ks, kf, lane);
        f32x4 st0[4], st1[4];
        {
          const int t0c = t0w; int lim = tqb - kbase - 8 * h; asm volatile("" : "+v"(lim));
          qk_part(kf, q0[0], q1[0], st0, !(kbase + 63 <= t0c && kbase > t0c + 3 - 512), [&](int cc) { return (cc <= lim) && (cc > lim - 512); }, lane);
        }
        {
          const int t0c = t0w + 4; int lim = tqb + 4 - kbase - 8 * h; asm volatile("" : "+v"(lim));
          qk_part(kf, q0[1], q1[1], st1, !(kbase + 63 <= t0c && kbase > t0c + 3 - 512), [&](int cc) { return (cc <= lim) && (cc > lim - 512); }, lane);
        }
        bf16x8 vf[8];
        load_k(Vs, vf, lane);
        sm_pv_part(st0, vf, m_run[0], l_run[0], o[0], true, lane);
        sm_pv_part(st1, vf, m_run[1], l_run[1], o[1], true, lane);
        if (u == 2 * nc + nw - 1) {
#pragma unroll
          for (int c = 0; c < 2; c++) {
            float lt = l_run[c]; lt += __shfl_xor(lt, 16); lt += __shfl_xor(lt, 32);
            EMIT_LDS(c, 2, lt, false);
          }
        }
      } else {
        const int blk = u - 2 * nc - nw;
        const unsigned long long um0 = rfl64(blk < 64 ? ulo[0] : uhi[0]), um1 = rfl64(blk < 64 ? ulo[1] : uhi[1]);
        const bool need0 = (um0 >> (blk & 63)) & 1ull, need1 = (um1 >> (blk & 63)) & 1ull;
        const int kbase = blk * 64;
        const bool domask = blk >= tb;
        if (need0 && need1) {
          const bool sel0 = ((blk < 64 ? mylo[0] : myhi[0]) >> (blk & 63)) & 1ull;
          const bool sel1 = ((blk < 64 ? mylo[1] : myhi[1]) >> (blk & 63)) & 1ull;
          bf16x8 kf[8];
          load_k(Ks, kf, lane);
          f32x4 st0[4], st1[4];
          { int lim = tqb - kbase - 8 * h; asm volatile("" : "+v"(lim)); qk_part(kf, q0[0], q1[0], st0, domask, [&](int cc) { return cc <= lim; }, lane); }
          { int lim = tqb + 4 - kbase - 8 * h; asm volatile("" : "+v"(lim)); qk_part(kf, q0[1], q1[1], st1, domask, [&](int cc) { return cc <= lim; }, lane); }
          bf16x8 vf[8];
          load_k(Vs, vf, lane);
          sm_pv_part(st0, vf, m_run[0], l_run[0], o[0], sel0, lane);
          sm_pv_part(st1, vf, m_run[1], l_run[1], o[1], sel1, lane);
        } else if (need0) {
          const bool sel0 = ((blk < 64 ? mylo[0] : myhi[0]) >> (blk & 63)) & 1ull;
          bf16x8 kf[8];
          load_k(Ks, kf, lane);
          f32x4 st0[4];
          { int lim = tqb - kbase - 8 * h; asm volatile("" : "+v"(lim)); qk_part(kf, q0[0], q1[0], st0, domask, [&](int cc) { return cc <= lim; }, lane); }
          bf16x8 vf[8];
          load_k(Vs, vf, lane);
          sm_pv_part(st0, vf, m_run[0], l_run[0], o[0], sel0, lane);
        } else if (need1) {
          const bool sel1 = ((blk < 64 ? mylo[1] : myhi[1]) >> (blk & 63)) & 1ull;
          bf16x8 kf[8];
          load_k(Ks, kf, lane);
          f32x4 st1[4];
          { int lim = tqb + 4 - kbase - 8 * h; asm volatile("" : "+v"(lim)); qk_part(kf, q0[1], q1[1], st1, domask, [&](int cc) { return cc <= lim; }, lane); }
          bf16x8 vf[8];
          load_k(Vs, vf, lane);
          sm_pv_part(st1, vf, m_run[1], l_run[1], o[1], sel1, lane);
        }
      }
    }
    if (s + 1 < nst) {
      u16* db = stg + ((s + 1) & 1) * 4 * STG;
      *(uint4*)(db + koff) = rk0; *(uint4*)(db + STG + voff) = rv0;
      *(uint4*)(db + 2 * STG + koff) = rk1; *(uint4*)(db + 3 * STG + voff) = rv1;
    }
    __syncthreads();
  }
#undef LDBLK
#pragma unroll
  for (int c = 0; c < 2; c++) {
    float lt = l_run[c]; lt += __shfl_xor(lt, 16); lt += __shfl_xor(lt, 32);
    EMIT_FINAL(c, 1, lt);
  }
#undef EMIT_GATE
#undef EMIT_LDS
#undef EMIT_FINAL
}

constexpr int N_PHASES = 2 + 9 * 4;

DI void run_phase(const P& p, int ph, char* smem, int* sh_next) {
  const int nb = gridDim.x, bid = blockIdx.x;
  u16* Hb = (u16*)(p.ws + OFF_H);
  u16* proj = (u16*)(p.ws + OFF_BIG);
  u16* mix = (u16*)(p.ws + OFF_MIX);
  if (ph == 0) {
    for (int it = bid; it < PREP_ITEMS; it += 2 * nb) {
      const int itb = it + nb;
      if (itb < PREP_TR) { const TJob ja = decode_tr(p, it), jb = decode_tr(p, itb); transpose_pair(ja, jb, smem); }
      else { prep_item(p, it, smem); if (itb < PREP_ITEMS) prep_item(p, itb, smem); }
    }
    return;
  }
  if (ph == 1) { for (int it = bid; it < T_ / 8; it += nb) ln_rows(p, 0, 0, it); return; }
  const int l = (ph - 2) / 9, k = (ph - 2) % 9;
  switch (k) {
    case 0: {
      Epi256InProj ef{proj, (u16*)(p.ws + OFF_VTS), (u16*)(p.ws + OFF_VTW), (const float*)(p.ws + OFF_COS), (const float*)(p.ws + OFF_SIN)};
      const u16* W = (const u16*)(p.ws + OFF_WIN) + (size_t)l * NPI * 1024;
      for (int it = bid; it < 12 * 128; it += nb) { int pm, pn; g_tile_map(it, 12, 128, pm, pn); gemm256_tile<true>(W, Hb, 1024, pm * 256, pn * 256, ef, smem); }
    } break;
    case 1: {
      unsigned* qc = (unsigned*)(p.ws + OFF_BAR + 14336) + l * 2;
      int it = bid;
      for (;;) {
        if (it >= 64 + 1024 + 2048) break;
        unsigned nx = 0;
        if (threadIdx.x == 0) nx = nb + __hip_atomic_fetch_add(qc, 1u, __ATOMIC_RELAXED, __HIP_MEMORY_SCOPE_AGENT);
        if (it < 64) {
          const int kv = it >> 5, r = it & 31;
          ACmp af{proj, kv ? 1664 : 1536};
          EpiPlain ef{(u16*)(p.ws + OFF_CH) + (size_t)kv * 4096 * 256, 256, 2, (const float*)(p.ws + OFF_CB) + (l * 2 + kv) * 256};
          gemm_tile(af, (const u16*)(p.ws + OFF_CW1) + (size_t)(l * 2 + kv) * 256 * 2048, 2048, (r >> 1) * 256, (r & 1) * 128, ef, smem);
        } else if (it < 64 + 1024) gmlp_item(p, l, it - 64, smem);
        else hgrn_item(p, l, it - 64 - 1024, 0, smem);
        if (threadIdx.x == 0) *sh_next = (int)nx;
        __syncthreads();
        it = *sh_next;
        __syncthreads();
      }
    } break;
    case 2: {
      for (int it = bid; it < 32 + 256; it += nb) {
        if (it < 32) {
          const int kv = it >> 4, r = it & 15;
          APlain af{(const u16*)(p.ws + OFF_CH) + (size_t)kv * 4096 * 256, 256};
          EpiCmp2 ef{(u16*)(p.ws + OFF_KC), (u16*)(p.ws + OFF_VCT), kv};
          gemm_tile(af, (const u16*)(p.ws + OFF_CW2) + (size_t)(l * 2 + kv) * 128 * 256, 256, r * 256, 0, ef, smem);
        } else scan_item(p, it - 32);
      }
    } break;
    case 3: {
      unsigned* qc = (unsigned*)(p.ws + OFF_BAR + 14336) + l * 2 + 1;
      int it = bid;
      for (;;) {
        if (it >= 1024 + 2048) break;
        unsigned nx = 0;
        if (threadIdx.x == 0) nx = nb + __hip_atomic_fetch_add(qc, 1u, __ATOMIC_RELAXED, __HIP_MEMORY_SCOPE_AGENT);
        if (it < 1024) nsa_item3(p, it, smem);
        else hgrn_item(p, l, it - 1024, 1, smem);
        if (threadIdx.x == 0) *sh_next = (int)nx;
        __syncthreads();
        it = *sh_next;
        __syncthreads();
      }
    } break;
    case 4: {
      Epi256Plain ef{(u16*)p.out, 1024, 0};
      const u16* W = (const u16*)(p.ws + OFF_WO) + (size_t)l * 1024 * 1024;
      for (int it = bid; it < 4 * 128; it += nb) { int pm, pn; g_tile_map(it, 4, 128, pm, pn); gemm256_tile<false>(W, mix, 1024, pm * 256, pn * 256, ef, smem); }
    } break;
    case 5: { for (int it = bid; it < T_ / 32; it += nb) ln_rows(p, l, 1, it); } break;
    case 6: {
      Epi256Plain ef{proj, 4096, 1};
      const u16* W = (const u16*)(p.ws + OFF_FF1) + (size_t)l * 4096 * 1024;
      for (int it = bid; it < 16 * 128; it += nb) { int pm, pn; g_tile_map(it, 16, 128, pm, pn); gemm256_tile<true>(W, Hb, 1024, pm * 256, pn * 256, ef, smem); }
    } break;
    case 7: {
      Epi256Plain ef{l == 3 ? (u16*)(p.ws + OFF_YL) : (u16*)p.out, 1024, 0};
      const u16* W = (const u16*)(p.ws + OFF_FF2) + (size_t)l * 1024 * 4096;
      for (int it = bid; it < 4 * 128; it += nb) { int pm, pn; g_tile_map(it, 4, 128, pm, pn); gemm256_tile<false>(W, proj, 4096, pm * 256, pn * 256, ef, smem); }
    } break;
    case 8: { for (int it = bid; it < T_ / 32; it += nb) ln_rows(p, l, 2, it); } break;
  }
}

#define XB_TMO      128
#define XB_XCNT(j)  (256  + 64 * (j))
#define XB_XSUB(j)  (1280 + 64 * (j))
#define XB_XGEN(j)  (2304 + 64 * (j))
#define XB_TOP      3328
#define XB_TOPGEN   3392
#define XCD_BAR_WORDS 3456
#define XB_SPIN_CAP (1u << 18)
#define LAS __attribute__((address_space(3)))
DI unsigned xb_ld(unsigned* p) { return __hip_atomic_load(p, __ATOMIC_RELAXED, __HIP_MEMORY_SCOPE_AGENT); }
DI unsigned xb_add(unsigned* p, unsigned v) { return __hip_atomic_fetch_add(p, v, __ATOMIC_RELAXED, __HIP_MEMORY_SCOPE_AGENT); }
DI unsigned xb_xcc_id() { return (unsigned)__builtin_amdgcn_s_getreg((3 << 11) | 20) & 0xFu; }
#define XB_SPIN(cond, bar) do { unsigned _sp = 0; while (cond) { __builtin_amdgcn_s_sleep(1); \
    if ((++_sp & 255u) == 0u) { if (xb_ld(&(bar)[XB_TMO])) break; if (_sp > XB_SPIN_CAP) { atomicAdd(&(bar)[XB_TMO], 1u); break; } } } } while (0)
struct XcdBarrier { unsigned* bar; unsigned x; volatile LAS unsigned* st; };
DI XcdBarrier xcd_barrier_post(unsigned* bar, volatile LAS unsigned* st) {
  XcdBarrier b; b.bar = bar; b.x = xb_xcc_id(); b.st = st;
  if (threadIdx.x == 0) (void)xb_add(&bar[XB_XCNT(b.x)], 1u);
  return b;
}
DI void xcd_barrier_complete(unsigned* bar, unsigned x, unsigned& nloc, unsigned& nx) {
  const unsigned G = gridDim.x * gridDim.y * gridDim.z;
  unsigned sum, cnt, mine, sp = 0u;
  for (;;) {
    sum = 0u; cnt = 0u; mine = 0u;
#pragma unroll
    for (unsigned j = 0; j < 16; ++j) { const unsigned c = xb_ld(&bar[XB_XCNT(j)]); sum += c; cnt += (c > 0u) ? 1u : 0u; mine = (j == x) ? c : mine; }
    if (sum == G) break;
    __builtin_amdgcn_s_sleep(1);
    if ((++sp & 255u) == 0u) { if (xb_ld(&bar[XB_TMO])) break; if (sp > XB_SPIN_CAP) { atomicAdd(&bar[XB_TMO], 1u); break; } }
  }
  nloc = mine > 0u ? mine : 1u; nx = cnt > 0u ? cnt : 1u;
}
DI void xcd_barrier(const XcdBarrier& b) {
  asm volatile("s_waitcnt vmcnt(0)" ::: "memory");
  __syncthreads();
  if (threadIdx.x == 0) {
    unsigned* bar = b.bar;
    __builtin_amdgcn_s_waitcnt(0);
    unsigned nloc = b.st[0], nx = b.st[1];
    if (nloc == 0u) { xcd_barrier_complete(bar, b.x, nloc, nx); b.st[0] = nloc; b.st[1] = nx; }
    const unsigned old = xb_add(&bar[XB_XSUB(b.x)], 1u);
    const unsigned gen = old / nloc;
    if (old + 1u == (gen + 1u) * nloc) {
      __builtin_amdgcn_fence(__ATOMIC_RELEASE, "agent");
      asm volatile("s_waitcnt vmcnt(0)" ::: "memory");
      const unsigned og = xb_add(&bar[XB_TOP], 1u);
      const unsigned tg = og / nx;
      if (og + 1u == (tg + 1u) * nx) xb_add(&bar[XB_TOPGEN], 1u);
      else XB_SPIN(xb_ld(&bar[XB_TOPGEN]) == tg, bar);
      __builtin_amdgcn_fence(__ATOMIC_ACQUIRE, "agent");
      xb_add(&bar[XB_XGEN(b.x)], 1u);
      asm volatile("s_waitcnt vmcnt(0)" ::: "memory");
    } else {
      XB_SPIN(xb_ld(&bar[XB_XGEN(b.x)]) == gen, bar);
      __builtin_amdgcn_fence(__ATOMIC_ACQUIRE, "agent");
      asm volatile("s_waitcnt vmcnt(0)" ::: "memory");
    }
  }
  __syncthreads();
}

__global__ void __launch_bounds__(NT) mega(P p) {
  extern __shared__ __attribute__((aligned(16))) char smem[];
#if MULTI_LAUNCH
  __shared__ int sh_next[4];
  for (int ph = p.ph_lo; ph < p.ph_hi; ph++) run_phase(p, ph, smem, sh_next);
#else
  __shared__ uint4 xb_words;
  __shared__ int sh_next[4];
  cg::grid_group grid = cg::this_grid();
  unsigned* bar = (unsigned*)(p.ws + OFF_BAR);
  if (threadIdx.x == 0) xb_words = make_uint4(0u, 0u, 0u, 0u);
  if (blockIdx.x == 0) { for (int i = threadIdx.x; i < 4096; i += NT) __hip_atomic_store(&bar[i], 0u, __ATOMIC_RELAXED, __HIP_MEMORY_SCOPE_AGENT); }
  __syncthreads();
  XcdBarrier xb;
  for (int ph = p.ph_lo; ph < p.ph_hi; ph++) {
    const int reps = (ph >= 2 && ((p.rep_mask >> ((ph - 2) % 9)) & 1)) ? 2 : 1;
    for (int rp = 0; rp < reps; rp++) { run_phase(p, ph, smem, sh_next); if (rp + 1 < reps) xcd_barrier(xb); }
    if (ph + 1 < p.ph_hi) {
      if (ph == p.ph_lo) { grid.sync(); xb = xcd_barrier_post(bar, (volatile LAS unsigned*)&xb_words); }
      else xcd_barrier(xb);
    }
  }
#endif
}

extern "C" void kernel_launch(void* const* d_in, const int* in_sizes, int n_in, void* d_out, int out_size, void* d_ws, size_t ws_size, hipStream_t stream) {
  static int grid_blocks = 0;
  if (!grid_blocks) {
    int dev = 0, cus = 0, per_cu = 0;
    hipGetDevice(&dev);
    hipDeviceGetAttribute(&cus, hipDeviceAttributeMultiprocessorCount, dev);
    hipFuncSetAttribute((const void*)mega, hipFuncAttributeMaxDynamicSharedMemorySize, SMEM_BYTES);
    hipOccupancyMaxActiveBlocksPerMultiprocessor(&per_cu, (const void*)mega, NT, SMEM_BYTES);
    if (per_cu < 1) per_cu = 1;
    grid_blocks = cus * per_cu;
    if (ws_size < WS_END) fprintf(stderr, "workspace too small: %zu < %zu\n", ws_size, (size_t)WS_END);
  }
  P p{};
  for (int i = 0; i < 25; i++) p.in[i] = (const float*)d_in[i];
  p.out = (float*)d_out;
  p.ws = (char*)d_ws;
  for (int i = 0; i < 32; i++) p.invf[i] = pow(10000.0, -(double)i / 32.0);
  {
    const double c[16] = {-1.0 / 6, 1.0 / 120, -1.0 / 5040, 1.0 / 362880, -1.0 / 39916800, 1.0 / 6227020800.0,
                          -0.5, 1.0 / 24, -1.0 / 720, 1.0 / 40320, -1.0 / 3628800, 1.0 / 479001600.0, -1.0 / 87178291200.0,
                          0.6366197723675814, 1.5707963267948966, 6.123233995736766e-17};
    for (int i = 0; i < 16; i++) p.cf[i] = c[i];
  }
#if MULTI_LAUNCH
  for (int ph = 0; ph < N_PHASES; ph++) {
    p.ph_lo = ph; p.ph_hi = ph + 1;
    hipLaunchKernelGGL(mega, dim3(grid_blocks), dim3(NT), SMEM_BYTES, stream, p);
  }
#else
  p.ph_lo = 0; p.ph_hi = N_PHASES; p.rep_mask = REPMASK;
  void* args[] = {&p};
  hipError_t e = hipLaunchCooperativeKernel((const void*)mega, dim3(grid_blocks), dim3(NT), args, SMEM_BYTES, stream);
  if (e != hipSuccess) fprintf(stderr, "cooperative launch failed: %s (grid %d)\n", hipGetErrorString(e), grid_blocks);
#endif
}
```

```cpp
#include <hip/hip_runtime.h>
#include <hip/hip_bf16.h>
#include <hip/hip_cooperative_groups.h>
#include <cstdio>
#include <cmath>
namespace cg = cooperative_groups;

#ifndef REPMASK
#define REPMASK 0
#endif
#ifndef MULTI_LAUNCH
#define MULTI_LAUNCH 0
#endif

typedef unsigned short u16;
using bf16x8 = __attribute__((ext_vector_type(8))) short;
using f32x16 = __attribute__((ext_vector_type(16))) float;
using f32x4 = __attribute__((ext_vector_type(4))) float;
#define DI __device__ __forceinline__

constexpr int NT = 512;
constexpr int T_ = 32768, S_ = 8192, D_ = 1024, PW = 2944, DFF = 4096;
constexpr float NEGF = -1e30f;
constexpr float DN_ALPHA = 1.681792830507429f;

constexpr size_t OFF_WIN = 0;
constexpr int NPI = 3072;
constexpr size_t OFF_WO  = OFF_WIN + 4ull * NPI * 1024 * 2;
constexpr size_t OFF_FF1 = OFF_WO + 4ull * 1024 * 1024 * 2;
constexpr size_t OFF_FF2 = OFF_FF1 + 4ull * 4096 * 1024 * 2;
constexpr size_t OFF_CW1 = OFF_FF2 + 4ull * 4096 * 1024 * 2;
constexpr size_t OFF_CW2 = OFF_CW1 + 4ull * 2 * 256 * 2048 * 2;
constexpr size_t OFF_MOD = OFF_CW2 + 4ull * 2 * 128 * 256 * 2;
constexpr size_t OFF_COS = OFF_MOD + 4ull * 4 * 6144 * 4;
constexpr size_t OFF_SIN = OFF_COS + (size_t)T_ * 32 * 4;
constexpr size_t OFF_LB  = OFF_SIN + (size_t)T_ * 32 * 4;
constexpr size_t OFF_CB  = OFF_LB + 4096;
constexpr size_t OFF_BAR = OFF_CB + 8192;
constexpr size_t OFF_WSB = OFF_BAR + 16384;
constexpr size_t OFF_H   = OFF_WSB + 524288;
constexpr size_t OFF_BIG = OFF_H + (size_t)T_ * 1024 * 2;
constexpr size_t OFF_MIX = OFF_BIG + (size_t)T_ * PW * 2;
constexpr size_t OFF_BIGEND = OFF_BIG + (size_t)T_ * 4096 * 2;
constexpr size_t OFF_VTS = OFF_BIGEND;
constexpr size_t OFF_VTW = OFF_VTS + 8388608;
constexpr size_t OFF_ST  = OFF_VTW + 8388608;
constexpr size_t OFF_DEC = OFF_ST + 33554432;
constexpr size_t OFF_CH  = OFF_DEC + 524288;
constexpr size_t OFF_KC  = OFF_CH + 4194304;
constexpr size_t OFF_VCT = OFF_KC + 524288;
constexpr size_t OFF_YL  = OFF_VTS;
constexpr size_t WS_END  = OFF_YL + (size_t)T_ * 1024 * 2;

struct P {
  const float* in[25];
  float* out;
  char* ws;
  double invf[32];
  double cf[16];
  int ph_lo, ph_hi;
  int rep_mask, pad_;
};

DI u16 f2bf(float x) { unsigned u = __float_as_uint(x); u += 0x7fffu + ((u >> 16) & 1u); return (u16)(u >> 16); }
DI float bf2f(u16 h) { return __uint_as_float(((unsigned)h) << 16); }
typedef __bf16 bf2_t __attribute__((ext_vector_type(2)));
typedef float f2_t __attribute__((ext_vector_type(2)));
DI unsigned pack2(float a, float b) { f2_t v = {a, b}; bf2_t r = __builtin_convertvector(v, bf2_t); return __builtin_bit_cast(unsigned, r); }
typedef _Float16 h8_t __attribute__((ext_vector_type(8)));
typedef _Float16 h2_t __attribute__((ext_vector_type(2)));
typedef float f2h_t __attribute__((ext_vector_type(2)));
DI unsigned pack2h(float a, float b) { f2h_t v = {a, b}; h2_t r = __builtin_convertvector(v, h2_t); return __builtin_bit_cast(unsigned, r); }
DI float hlo2f(unsigned u) { return (float)__builtin_bit_cast(_Float16, (unsigned short)(u & 0xffffu)); }
DI float hhi2f(unsigned u) { return (float)__builtin_bit_cast(_Float16, (unsigned short)(u >> 16)); }
DI float lo2f(unsigned u) { return __uint_as_float(u << 16); }
DI float hi2f(unsigned u) { return __uint_as_float(u & 0xffff0000u); }
DI int tidx() { int t = threadIdx.x; asm volatile("" : "+v"(t)); return t; }
DI float sigm(float x) { return 1.f / (1.f + __expf(-x)); }
DI float silu(float x) { return x / (1.f + __expf(-x)); }
DI float gelu_t(float x) { float u = 0.7978845608028654f * (x + 0.044715f * x * x * x); return x / (1.f + __expf(-2.f * u)); }
DI f32x16 mfma32(bf16x8 a, bf16x8 b, f32x16 c) { return __builtin_amdgcn_mfma_f32_32x32x16_bf16(a, b, c, 0, 0, 0); }
DI f32x4 mfma16(bf16x8 a, bf16x8 b, f32x4 c) { return __builtin_amdgcn_mfma_f32_16x16x32_bf16(a, b, c, 0, 0, 0); }
DI float wsum(float v) { for (int o = 32; o > 0; o >>= 1) v += __shfl_xor(v, o); return v; }
DI void unpack8(uint4 r, float* f) {
  f[0] = lo2f(r.x); f[1] = hi2f(r.x); f[2] = lo2f(r.y); f[3] = hi2f(r.y);
  f[4] = lo2f(r.z); f[5] = hi2f(r.z); f[6] = lo2f(r.w); f[7] = hi2f(r.w);
}

constexpr int BM = 256, BN = 128, BK = 64, LDT = 72;
constexpr int SMEM_BYTES = 147456;

struct APlain { const u16* A; int lda; DI const u16* operator()(int row, int kt) const { return A + (size_t)row * lda + kt * 64; } };
struct ACmp { const u16* proj; int col0;
  DI const u16* operator()(int row, int kt) const {
    int n = row & 511, bh = row >> 9, b = bh >> 1, hk = bh & 1;
    int s = 16 * n + kt; s = s < S_ ? s : S_ - 1;
    return proj + (size_t)(b * S_ + s) * PW + col0 + hk * 64;
  } };

template <class AF, class EF>
DI void gemm_tile(AF af, const u16* __restrict__ Bt, int K, int m0, int n0, EF ef, char* smem) {
  u16* sA = (u16*)smem;
  u16* sB = sA + 2 * BM * LDT;
  const int tid = tidx(), lane = tid & 63, wid = tid >> 6, wm = wid >> 1, wn = wid & 1;
  const int cr = tid >> 3, cc = (tid & 7) * 8;
  f32x16 acc[2][2];
#pragma unroll
  for (int i = 0; i < 2; i++)
#pragma unroll
    for (int j = 0; j < 2; j++)
#pragma unroll
      for (int r = 0; r < 16; r++) acc[i][j][r] = 0.f;
  uint4 ra[4], rb[2];
  const int nk = K / BK;
#pragma unroll
  for (int i = 0; i < 4; i++) ra[i] = *(const uint4*)(af(m0 + cr + i * 64, 0) + cc);
#pragma unroll
  for (int i = 0; i < 2; i++) rb[i] = *(const uint4*)(Bt + (size_t)(n0 + cr + i * 64) * K + cc);
#pragma unroll
  for (int i = 0; i < 4; i++) *(uint4*)(sA + (cr + i * 64) * LDT + cc) = ra[i];
#pragma unroll
  for (int i = 0; i < 2; i++) *(uint4*)(sB + (cr + i * 64) * LDT + cc) = rb[i];
  __syncthreads();
  for (int kt = 0; kt < nk; kt++) {
    const int cur = kt & 1;
    if (kt + 1 < nk) {
#pragma unroll
      for (int i = 0; i < 4; i++) ra[i] = *(const uint4*)(af(m0 + cr + i * 64, kt + 1) + cc);
#pragma unroll
      for (int i = 0; i < 2; i++) rb[i] = *(const uint4*)(Bt + (size_t)(n0 + cr + i * 64) * K + (kt + 1) * 64 + cc);
    }
    const u16* a_ = sA + cur * BM * LDT + (wm * 64 + (lane & 31)) * LDT + (lane >> 5) * 8;
    const u16* b_ = sB + cur * BN * LDT + (wn * 64 + (lane & 31)) * LDT + (lane >> 5) * 8;
#pragma unroll
    for (int ks = 0; ks < 4; ks++) {
      bf16x8 fa0 = *(const bf16x8*)(a_ + ks * 16), fa1 = *(const bf16x8*)(a_ + 32 * LDT + ks * 16);
      bf16x8 fb0 = *(const bf16x8*)(b_ + ks * 16), fb1 = *(const bf16x8*)(b_ + 32 * LDT + ks * 16);
      acc[0][0] = mfma32(fb0, fa0, acc[0][0]);
      acc[0][1] = mfma32(fb1, fa0, acc[0][1]);
      acc[1][0] = mfma32(fb0, fa1, acc[1][0]);
      acc[1][1] = mfma32(fb1, fa1, acc[1][1]);
    }
    if (kt + 1 < nk) {
      u16* dA = sA + (cur ^ 1) * BM * LDT;
      u16* dB = sB + (cur ^ 1) * BN * LDT;
#pragma unroll
      for (int i = 0; i < 4; i++) *(uint4*)(dA + (cr + i * 64) * LDT + cc) = ra[i];
#pragma unroll
      for (int i = 0; i < 2; i++) *(uint4*)(dB + (cr + i * 64) * LDT + cc) = rb[i];
    }
    __syncthreads();
  }
  ef(m0 + wm * 64, n0 + wn * 64, acc, lane);
}

struct EpiPlain {
  u16* out; int ldo; int act; const float* bias;
  DI void operator()(int tm0, int tn0, f32x16 (&acc)[2][2], int lane) const {
    const int h = lane >> 5;
#pragma unroll
    for (int mi = 0; mi < 2; mi++) {
      const size_t row = (size_t)(tm0 + mi * 32 + (lane & 31));
#pragma unroll
      for (int ni = 0; ni < 2; ni++)
#pragma unroll
        for (int q = 0; q < 4; q++) {
          const int col = tn0 + ni * 32 + 8 * q + 4 * h;
          float v[4];
#pragma unroll
          for (int j = 0; j < 4; j++) {
            float x = acc[mi][ni][4 * q + j];
            if (act == 1) { x = fmaxf(x, 0.f); x = x * x; }
            else if (act == 2) { x = gelu_t(x + bias[col + j]); }
            v[j] = x;
          }
          uint2 pk; pk.x = pack2(v[0], v[1]); pk.y = pack2(v[2], v[3]);
          *(uint2*)(out + row * ldo + col) = pk;
        }
    }
  }
};

struct EpiInProj {
  u16* proj; u16* vts; u16* vtw; const float* cs; const float* sn;
  DI void operator()(int tm0, int tn0, f32x16 (&acc)[2][2], int lane) const {
    const int h = lane >> 5;
    const bool isrope = (tn0 >= 1024 && tn0 < 1664) || (tn0 >= 1792 && tn0 < 1920) || (tn0 >= 2048 && tn0 < 2176);
    const float scale = (tn0 >= 1024 && tn0 < 1536) ? 0.125f : 1.f;
    const bool isvts = (tn0 >= 1920 && tn0 < 2048), isvtw = (tn0 >= 2176 && tn0 < 2304);
#pragma unroll
    for (int mi = 0; mi < 2; mi++) {
      const int token = tm0 + mi * 32 + (lane & 31);
      if (isrope) {
#pragma unroll
        for (int q = 0; q < 4; q++) {
          const int d0 = 8 * q + 4 * h;
          const float4 c4 = *(const float4*)(cs + (size_t)token * 32 + d0);
          const float4 s4 = *(const float4*)(sn + (size_t)token * 32 + d0);
          const float cc[4] = {c4.x, c4.y, c4.z, c4.w}, ss[4] = {s4.x, s4.y, s4.z, s4.w};
#pragma unroll
          for (int j = 0; j < 4; j++) {
            const float a1 = acc[mi][0][4 * q + j], a2 = acc[mi][1][4 * q + j];
            acc[mi][0][4 * q + j] = (a1 * cc[j] - a2 * ss[j]) * scale;
            acc[mi][1][4 * q + j] = (a2 * cc[j] + a1 * ss[j]) * scale;
          }
        }
      }
      if (isvts || isvtw) {
        const int b = token / S_, s = token % S_;
        const int hk = ((tn0 - (isvts ? 1920 : 2176)) >> 6);
        u16* vt = (isvts ? vts : vtw) + (size_t)((b * 2 + hk) * 64) * S_ + s;
#pragma unroll
        for (int ni = 0; ni < 2; ni++)
#pragma unroll
          for (int r = 0; r < 16; r++) {
            const int dim = ni * 32 + 8 * (r >> 2) + 4 * h + (r & 3);
            vt[(size_t)dim * S_] = f2bf(acc[mi][ni][r]);
          }
      } else {
#pragma unroll
        for (int ni = 0; ni < 2; ni++)
#pragma unroll
          for (int q = 0; q < 4; q++) {
            const int col = tn0 + ni * 32 + 8 * q + 4 * h;
            uint2 pk; pk.x = pack2(acc[mi][ni][4 * q], acc[mi][ni][4 * q + 1]); pk.y = pack2(acc[mi][ni][4 * q + 2], acc[mi][ni][4 * q + 3]);
            *(uint2*)(proj + (size_t)token * PW + col) = pk;
          }
      }
    }
  }
};

struct EpiCmp2 {
  u16* kc; u16* vct; int kv;
  DI void operator()(int tm0, int tn0, f32x16 (&acc)[2][2], int lane) const {
    if (tn0 >= 64) return;
    const int h = lane >> 5;
#pragma unroll
    for (int mi = 0; mi < 2; mi++) {
      const int row = tm0 + mi * 32 + (lane & 31);
      const int n = row & 511, bh = row >> 9;
#pragma unroll
      for (int ni = 0; ni < 2; ni++)
#pragma unroll
        for (int r = 0; r < 16; r++) {
          const int dim = ni * 32 + 8 * (r >> 2) + 4 * h + (r & 3);
          const u16 v = f2bf(acc[mi][ni][r]);
          if (kv == 0) kc[(size_t)row * 64 + dim] = v;
          else vct[(size_t)(bh * 64 + dim) * 512 + n] = v;
        }
    }
  }
};


constexpr int G_BK = 64, G_HALF = 128, G_HT = G_HALF * G_BK;
constexpr int G_SHM = 8 * G_HT * 2;
DI int g_lds_byte(int r, int c) {
  int st = (r >> 4) * 2 + (c >> 5), rr = r & 15, cc = c & 31, ob = rr * 64 + cc * 2;
  return st * 1024 + (ob ^ (((ob >> 9) & 1) << 5));
}
DI void g_stage_rc(int b, int& R, int& C) {
  int st = b / 1024, sb = b % 1024, swz = sb ^ (((sb >> 9) & 1) << 5);
  R = (st >> 1) * 16 + swz / 64; C = (st & 1) * 32 + (swz % 64) / 2;
}
template <bool F16, class EF>
DI void gemm256_tile(const u16* __restrict__ A, const u16* __restrict__ Bt, int K, int brow, int bcol, EF ef, char* smem) {
  u16* shm = (u16*)smem;
  const int tid = tidx();
#define SA(b, h) (shm + ((b) * 2 + (h)) * G_HT)
#define SB(b, h) (shm + (4 + (b) * 2 + (h)) * G_HT)
#define STAGE(P_, BASE, br, kt) do { const u16* _gb = (BASE) + ((long)(br) * K + (long)(kt) * G_BK); \
    __builtin_amdgcn_global_load_lds((const unsigned*)(_gb + so0), (__attribute__((address_space(3))) unsigned*)((char*)(P_) + tid * 16), 16, 0, 0); \
    __builtin_amdgcn_global_load_lds((const unsigned*)(_gb + so1), (__attribute__((address_space(3))) unsigned*)((char*)(P_) + tid * 16 + 8192), 16, 0, 0); } while (0)
#define LDA(dst, b, h) for (int m = 0; m < 4; ++m) for (int k = 0; k < 2; ++k) \
    dst[m][k] = *reinterpret_cast<const bf16x8*>((char*)SA(b, h) + g_lds_byte(wr * 64 + m * 16 + fr, k * 32 + fq * 8))
#define LDB(dst, b, h) for (int n = 0; n < 2; ++n) for (int k = 0; k < 2; ++k) \
    dst[n][k] = *reinterpret_cast<const bf16x8*>((char*)SB(b, h) + g_lds_byte(wc * 32 + n * 16 + fr, k * 32 + fq * 8))
#define MMA(ai, bj, At_, Bt_) do { __builtin_amdgcn_s_setprio(1); \
    for (int m = 0; m < 4; ++m) for (int n = 0; n < 2; ++n) for (int k = 0; k < 2; ++k) \
      acc[ai][bj][m][n] = F16 ? __builtin_amdgcn_mfma_f32_16x16x32_f16(__builtin_bit_cast(h8_t, At_[m][k]), __builtin_bit_cast(h8_t, Bt_[n][k]), acc[ai][bj][m][n], 0, 0, 0) \
                              : __builtin_amdgcn_mfma_f32_16x16x32_bf16(At_[m][k], Bt_[n][k], acc[ai][bj][m][n], 0, 0, 0); \
    __builtin_amdgcn_s_setprio(0); } while (0)
#define WAIT_V(n) asm volatile("s_waitcnt vmcnt(" #n ")" ::: "memory")
#define WAIT_L(n) asm volatile("s_waitcnt lgkmcnt(" #n ")" ::: "memory")
#define BAR __builtin_amdgcn_s_barrier()
#define SCHED __builtin_amdgcn_sched_barrier(0)
  const int wid = tid >> 6, lane = tid & 63, wr = wid >> 2, wc = wid & 3, fr = lane & 15, fq = lane >> 4;
  unsigned so0, so1;
  { int r_, c_; g_stage_rc(tid * 16, r_, c_); so0 = (unsigned)(r_ * K + c_); g_stage_rc(tid * 16 + 8192, r_, c_); so1 = (unsigned)(r_ * K + c_); }
  f32x4 acc[2][2][4][2] = {};
  bf16x8 At[4][2], B0[2][2], B1[2][2];
  const int nt = K / G_BK;
  STAGE(SB(0, 0), Bt, bcol, 0); STAGE(SA(0, 0), A, brow, 0);
  STAGE(SB(0, 1), Bt, bcol + G_HALF, 0); STAGE(SA(0, 1), A, brow + G_HALF, 0);
  if (wr == 1) BAR;
  WAIT_V(4); BAR;
  STAGE(SB(1, 0), Bt, bcol, 1); STAGE(SA(1, 0), A, brow, 1); STAGE(SB(1, 1), Bt, bcol + G_HALF, 1);
  WAIT_V(6); BAR;
  for (int t = 0; t < nt - 2; t += 2) {
    LDB(B0, 0, 0); SCHED; LDA(At, 0, 0); STAGE(SA(1, 1), A, brow + G_HALF, t + 1);
    WAIT_L(8); BAR; WAIT_L(0); MMA(0, 0, At, B0); BAR; SCHED;
    LDB(B1, 0, 1); STAGE(SB(0, 0), Bt, bcol, t + 2);
    BAR; WAIT_L(0); MMA(0, 1, At, B1); BAR;
    LDA(At, 0, 1); STAGE(SA(0, 0), A, brow, t + 2);
    BAR; WAIT_L(0); MMA(1, 0, At, B0); BAR; SCHED;
    STAGE(SB(0, 1), Bt, bcol + G_HALF, t + 2);
    WAIT_V(6); BAR; MMA(1, 1, At, B1); BAR;
    LDB(B0, 1, 0); SCHED; LDA(At, 1, 0); STAGE(SA(0, 1), A, brow + G_HALF, t + 2);
    WAIT_L(8); BAR; WAIT_L(0); MMA(0, 0, At, B0); BAR; SCHED;
    LDB(B1, 1, 1); STAGE(SB(1, 0), Bt, bcol, t + 3);
    BAR; WAIT_L(0); MMA(0, 1, At, B1); BAR;
    LDA(At, 1, 1); STAGE(SA(1, 0), A, brow, t + 3);
    BAR; WAIT_L(0); MMA(1, 0, At, B0); BAR; SCHED;
    STAGE(SB(1, 1), Bt, bcol + G_HALF, t + 3);
    WAIT_V(6); BAR; MMA(1, 1, At, B1); BAR;
  }
  { LDB(B0, 0, 0); LDA(At, 0, 0); STAGE(SA(1, 1), A, brow + G_HALF, nt - 1);
    BAR; WAIT_L(0); MMA(0, 0, At, B0); BAR;
    LDB(B1, 0, 1); BAR; WAIT_L(0); MMA(0, 1, At, B1); BAR;
    LDA(At, 0, 1); WAIT_V(4); BAR; WAIT_L(0); MMA(1, 0, At, B0); MMA(1, 1, At, B1); BAR; }
  { LDB(B0, 1, 0); LDA(At, 1, 0); WAIT_V(2); BAR; WAIT_L(0); MMA(0, 0, At, B0); BAR;
    LDB(B1, 1, 1); WAIT_V(0); BAR; WAIT_L(0); MMA(0, 1, At, B1); BAR;
    LDA(At, 1, 1); BAR; WAIT_L(0); MMA(1, 0, At, B0); MMA(1, 1, At, B1); BAR; }
  if (wr == 0) BAR;
  ef(brow + wr * 64, bcol + wc * 32, fr, fq, acc);
  __syncthreads();
#undef SA
#undef SB
#undef STAGE
#undef LDA
#undef LDB
#undef MMA
#undef WAIT_V
#undef WAIT_L
#undef BAR
#undef SCHED
}
DI void g_tile_map(int wgid, int nM, int nN, int& pm, int& pn) {
  const int nwg = nM * nN;
  { int q = nwg / 8, r = nwg % 8, xcd = wgid % 8, off = wgid / 8; wgid = (xcd < r ? xcd * (q + 1) : r * (q + 1) + (xcd - r) * q) + off; }
  const int nig = 8 * nN, gid = wgid / nig, fm = gid * 8, gsz = min(nM - fm, 8);
  pm = fm + ((wgid % nig) % gsz); pn = (wgid % nig) / gsz;
}

struct Epi256Plain {
  u16* out; int ldo; int act;
  DI void operator()(int f0, int t0, int fr, int fq, f32x4 (&acc)[2][2][4][2]) const {
    const int fo = (fq & 1) ? 16 + 4 * (fq - 1) : 4 * fq;
#pragma unroll
    for (int ai = 0; ai < 2; ai++)
#pragma unroll
      for (int bj = 0; bj < 2; bj++)
#pragma unroll
        for (int n = 0; n < 2; n++) {
          const size_t token = (size_t)(t0 + bj * 128 + n * 16 + fr);
#pragma unroll
          for (int mp = 0; mp < 2; mp++) {
            unsigned pa[2], pb[2];
#pragma unroll
            for (int e = 0; e < 2; e++) {
              const int m = mp * 2 + e;
              float v[4];
#pragma unroll
              for (int j = 0; j < 4; j++) { float x = acc[ai][bj][m][n][j]; if (act == 1) { x = fmaxf(x, 0.f); x = x * x; } v[j] = x; }
              if (e == 0) { pa[0] = pack2(v[0], v[1]); pa[1] = pack2(v[2], v[3]); } else { pb[0] = pack2(v[0], v[1]); pb[1] = pack2(v[2], v[3]); }
            }
            auto r0 = __builtin_amdgcn_permlane16_swap(pa[0], pb[0], false, false);
            auto r1 = __builtin_amdgcn_permlane16_swap(pa[1], pb[1], false, false);
            uint4 pk; pk.x = r0[0]; pk.y = r1[0]; pk.z = r0[1]; pk.w = r1[1];
            *(uint4*)(out + token * ldo + f0 + ai * 128 + mp * 32 + fo) = pk;
          }
        }
  }
};

struct Epi256InProj {
  u16* proj; u16* vts; u16* vtw; const float* cs; const float* sn;
  DI void operator()(int f0, int t0, int fr, int fq, f32x4 (&acc)[2][2][4][2]) const {
#pragma unroll
    for (int ai = 0; ai < 2; ai++) {
      const int fb = f0 + ai * 128;
      if (fb >= PW) continue;
      const bool isrope = (fb >= 1024 && fb < 1664) || (fb >= 1792 && fb < 1920) || (fb >= 2048 && fb < 2176);
      const float scale = (fb >= 1024 && fb < 1536) ? 0.125f : 1.f;
      const bool isvts = (fb >= 1920 && fb < 2048), isvtw = (fb >= 2176 && fb < 2304);
#pragma unroll
      for (int bj = 0; bj < 2; bj++)
#pragma unroll
        for (int n = 0; n < 2; n++) {
          const int token = t0 + bj * 128 + n * 16 + fr;
          if (isrope) {
#pragma unroll
            for (int m = 0; m < 2; m++) {
              const int d0 = m * 16 + fq * 4;
              const float4 c4 = *(const float4*)(cs + (size_t)token * 32 + d0);
              const float4 s4 = *(const float4*)(sn + (size_t)token * 32 + d0);
              const float cc[4] = {c4.x, c4.y, c4.z, c4.w}, ss[4] = {s4.x, s4.y, s4.z, s4.w};
#pragma unroll
              for (int j = 0; j < 4; j++) {
                const float a1 = acc[ai][bj][m][n][j], a2 = acc[ai][bj][m + 2][n][j];
                acc[ai][bj][m][n][j] = (a1 * cc[j] - a2 * ss[j]) * scale;
                acc[ai][bj][m + 2][n][j] = (a2 * cc[j] + a1 * ss[j]) * scale;
              }
            }
          }
          if (isvts || isvtw) {
            const int b = token / S_, s = token % S_;
            const int hk = ((fb - (isvts ? 1920 : 2176)) >> 6);
            u16* vt = (isvts ? vts : vtw) + (size_t)((b * 2 + hk) * 64) * S_ + s;
#pragma unroll
            for (int m = 0; m < 4; m++)
#pragma unroll
              for (int j = 0; j < 4; j++) vt[(size_t)(m * 16 + fq * 4 + j) * S_] = f2bf(acc[ai][bj][m][n][j]);
          } else {
            const int fo = (fq & 1) ? 16 + 4 * (fq - 1) : 4 * fq;
#pragma unroll
            for (int mp = 0; mp < 2; mp++) {
              const unsigned a0 = pack2(acc[ai][bj][2 * mp][n][0], acc[ai][bj][2 * mp][n][1]), a1 = pack2(acc[ai][bj][2 * mp][n][2], acc[ai][bj][2 * mp][n][3]);
              const unsigned b0 = pack2(acc[ai][bj][2 * mp + 1][n][0], acc[ai][bj][2 * mp + 1][n][1]), b1 = pack2(acc[ai][bj][2 * mp + 1][n][2], acc[ai][bj][2 * mp + 1][n][3]);
              auto r0 = __builtin_amdgcn_permlane16_swap(a0, b0, false, false);
              auto r1 = __builtin_amdgcn_permlane16_swap(a1, b1, false, false);
              uint4 pk; pk.x = r0[0]; pk.y = r1[0]; pk.z = r0[1]; pk.w = r1[1];
              *(uint4*)(proj + (size_t)token * PW + fb + mp * 32 + fo) = pk;
            }
          }
        }
    }
  }
};

DI void transpose_tile(const float* __restrict__ W, int K, int N, u16* __restrict__ dst, int kt, int nt_, char* smem) {
  float* tile = (float*)smem;
  const int tid = tidx();
  const int k0 = kt * 64, n0 = nt_ * 64;
  {
    const int r = tid >> 4, c4 = (tid & 15) * 4;
#pragma unroll
    for (int rr = 0; rr < 2; rr++) {
      const int k = r + rr * 32;
      float4 v = make_float4(0.f, 0.f, 0.f, 0.f);
      if (n0 + c4 < N) v = *(const float4*)(W + (size_t)(k0 + k) * N + n0 + c4);
      tile[k * 65 + c4] = v.x; tile[k * 65 + c4 + 1] = v.y; tile[k * 65 + c4 + 2] = v.z; tile[k * 65 + c4 + 3] = v.w;
    }
  }
  __syncthreads();
  {
    const int n = tid >> 3, k8 = (tid & 7) * 8;
    uint4 o;
    o.x = pack2(tile[(k8 + 0) * 65 + n], tile[(k8 + 1) * 65 + n]);
    o.y = pack2(tile[(k8 + 2) * 65 + n], tile[(k8 + 3) * 65 + n]);
    o.z = pack2(tile[(k8 + 4) * 65 + n], tile[(k8 + 5) * 65 + n]);
    o.w = pack2(tile[(k8 + 6) * 65 + n], tile[(k8 + 7) * 65 + n]);
    *(uint4*)(dst + (size_t)(n0 + n) * K + k0 + k8) = o;
  }
  __syncthreads();
}

struct TJob { const float* W; int K, N; u16* dst; int kt, nt; int f16; };
template <int NJ>
DI void transpose_multi(const TJob (&jb)[NJ], char* smem) {
  float* tile = (float*)smem;
  const int tid = tidx();
  const int r = tid >> 4, c4 = (tid & 15) * 4;
  float4 va[NJ][2];
#pragma unroll
  for (int e = 0; e < NJ; e++)
#pragma unroll
    for (int rr = 0; rr < 2; rr++) {
      const int k = r + rr * 32;
      va[e][rr] = make_float4(0.f, 0.f, 0.f, 0.f);
      if (jb[e].nt * 64 + c4 < jb[e].N) va[e][rr] = *(const float4*)(jb[e].W + (size_t)(jb[e].kt * 64 + k) * jb[e].N + jb[e].nt * 64 + c4);
    }
#pragma unroll
  for (int e = 0; e < NJ; e++)
#pragma unroll
    for (int rr = 0; rr < 2; rr++) {
      const int k = r + rr * 32;
      float* ta = tile + e * 64 * 65 + k * 65 + c4;
      ta[0] = va[e][rr].x; ta[1] = va[e][rr].y; ta[2] = va[e][rr].z; ta[3] = va[e][rr].w;
    }
  __syncthreads();
  {
    const int n = tid >> 3, k8 = (tid & 7) * 8;
#pragma unroll
    for (int e = 0; e < NJ; e++) {
      const float* t = tile + e * 64 * 65;
      const TJob& j = jb[e];
      uint4 o;
      if (j.f16) {
        o.x = pack2h(t[(k8 + 0) * 65 + n], t[(k8 + 1) * 65 + n]);
        o.y = pack2h(t[(k8 + 2) * 65 + n], t[(k8 + 3) * 65 + n]);
        o.z = pack2h(t[(k8 + 4) * 65 + n], t[(k8 + 5) * 65 + n]);
        o.w = pack2h(t[(k8 + 6) * 65 + n], t[(k8 + 7) * 65 + n]);
      } else {
        o.x = pack2(t[(k8 + 0) * 65 + n], t[(k8 + 1) * 65 + n]);
        o.y = pack2(t[(k8 + 2) * 65 + n], t[(k8 + 3) * 65 + n]);
        o.z = pack2(t[(k8 + 4) * 65 + n], t[(k8 + 5) * 65 + n]);
        o.w = pack2(t[(k8 + 6) * 65 + n], t[(k8 + 7) * 65 + n]);
      }
      *(uint4*)(j.dst + (size_t)(j.nt * 64 + n) * j.K + j.kt * 64 + k8) = o;
    }
  }
  __syncthreads();
}
DI void transpose_pair(const TJob& ja, const TJob& jb2, char* smem) { const TJob js[2] = {ja, jb2}; transpose_multi<2>(js, smem); }

template <int NB, bool SILU>
DI void gemv_tile(const float* __restrict__ a, int lda, const float* __restrict__ W, int K, int N, int n0, const float* bias, float* out, int ldo, char* smem) {
  float* red = (float*)smem;
  const int tid = tidx(), nn = tid & 63, ks = tid >> 6;
  float acc[NB];
#pragma unroll
  for (int r = 0; r < NB; r++) acc[r] = 0.f;
  const int kl = K / 8;
  for (int k = ks * kl; k < (ks + 1) * kl; k++) {
    const float w = W[(size_t)k * N + n0 + nn];
#pragma unroll
    for (int r = 0; r < NB; r++) { float av = a[r * lda + k]; if (SILU) av = silu(av); acc[r] += av * w; }
  }
#pragma unroll
  for (int r = 0; r < NB; r++) red[(ks * NB + r) * 64 + nn] = acc[r];
  __syncthreads();
  if (tid < NB * 64) {
    const int r = tid >> 6;
    float s = 0.f;
#pragma unroll
    for (int j = 0; j < 8; j++) s += red[(j * NB + r) * 64 + nn];
    if (bias) s += bias[n0 + nn];
    out[r * ldo + n0 + nn] = s;
  }
  __syncthreads();
}

constexpr int TR_PER_LAYER = 768 + 256 + 1024 + 1024 + 128 + 128 + 8 + 8;
constexpr int PREP_TR = 4 * TR_PER_LAYER;
constexpr int PREP_MOD = 4 * 96;
constexpr int PREP_CB = 4 * 2 * 4;
constexpr int PREP_ROPE = 512;
constexpr int PREP_WSB = 128;
constexpr int PREP_ITEMS = PREP_TR + PREP_MOD + PREP_CB + PREP_ROPE + PREP_WSB + 1;

DI TJob decode_tr(const P& p, int item) {
  const int l = item / TR_PER_LAYER; int r = item % TR_PER_LAYER;
  TJob j; j.f16 = 0;
  if (r < 768) { j.f16 = 1; j.W = p.in[3] + (size_t)l * 1024 * 2840; j.K = 1024; j.N = 2840; j.dst = (u16*)(p.ws + OFF_WIN) + (size_t)l * NPI * 1024; j.kt = r / 48; j.nt = r % 48; return j; }
  r -= 768;
  if (r < 256) { j.W = p.in[4] + (size_t)l * 1024 * 1024; j.K = 1024; j.N = 1024; j.dst = (u16*)(p.ws + OFF_WO) + (size_t)l * 1024 * 1024; j.kt = r / 16; j.nt = r % 16; return j; }
  r -= 256;
  if (r < 1024) { j.f16 = 1; j.W = p.in[17] + (size_t)l * 1024 * 4096; j.K = 1024; j.N = 4096; j.dst = (u16*)(p.ws + OFF_FF1) + (size_t)l * 4096 * 1024; j.kt = r / 64; j.nt = r % 64; return j; }
  r -= 1024;
  if (r < 1024) { j.W = p.in[18] + (size_t)l * 4096 * 1024; j.K = 4096; j.N = 1024; j.dst = (u16*)(p.ws + OFF_FF2) + (size_t)l * 1024 * 4096; j.kt = r / 16; j.nt = r % 16; return j; }
  r -= 1024;
  if (r < 256) { const int kv = r >> 7; r &= 127; j.W = p.in[kv ? 11 : 8] + (size_t)l * 2048 * 256; j.K = 2048; j.N = 256; j.dst = (u16*)(p.ws + OFF_CW1) + (size_t)(l * 2 + kv) * 256 * 2048; j.kt = r / 4; j.nt = r % 4; return j; }
  r -= 256;
  { const int kv = r >> 3; r &= 7; j.W = p.in[kv ? 12 : 9] + (size_t)l * 256 * 64; j.K = 256; j.N = 64; j.dst = (u16*)(p.ws + OFF_CW2) + (size_t)(l * 2 + kv) * 128 * 256; j.kt = r / 2; j.nt = r % 2; return j; }
}

DI void prep_item(const P& p, int item, char* smem) {
  const int tid = tidx();
  if (item < PREP_TR) { const TJob j = decode_tr(p, item); transpose_pair(j, j, smem); return; }
  item -= PREP_TR;
  if (item < PREP_MOD) {
    const int l = item / 96, nt_ = item % 96;
    gemv_tile<4, true>(p.in[1], 1024, p.in[19] + (size_t)l * 1024 * 6144, 1024, 6144, nt_ * 64, p.in[20] + l * 6144,
                       (float*)(p.ws + OFF_MOD) + (size_t)l * 4 * 6144, 6144, smem);
    return;
  }
  item -= PREP_MOD;
  if (item < PREP_CB) {
    const int l = item >> 3, kv = (item >> 2) & 1, nt_ = item & 3;
    gemv_tile<1, false>(p.in[kv ? 10 : 7] + (size_t)l * 2048, 2048, p.in[kv ? 11 : 8] + (size_t)l * 2048 * 256, 2048, 256, nt_ * 64, nullptr,
                        (float*)(p.ws + OFF_CB) + (l * 2 + kv) * 256, 256, smem);
    return;
  }
  item -= PREP_CB;
  if (item < PREP_ROPE) {
    float* cs = (float*)(p.ws + OFF_COS); float* sn = (float*)(p.ws + OFF_SIN);
    const int* pos = (const int*)p.in[2];
#pragma unroll
    for (int j = 0; j < 4; j++) {
      const int idx = item * 2048 + j * 512 + tid;
      const int tok = idx >> 5, i = idx & 31;
      const double ang = (double)pos[tok] * p.invf[i];
      const double qd = rint(ang * p.cf[13]);
      const double r = (ang - qd * p.cf[14]) - qd * p.cf[15];
      const double r2 = r * r;
      const double sr = r * (1.0 + r2 * (p.cf[0] + r2 * (p.cf[1] + r2 * (p.cf[2] + r2 * (p.cf[3] + r2 * (p.cf[4] + r2 * p.cf[5]))))));
      const double cr = 1.0 + r2 * (p.cf[6] + r2 * (p.cf[7] + r2 * (p.cf[8] + r2 * (p.cf[9] + r2 * (p.cf[10] + r2 * (p.cf[11] + r2 * p.cf[12]))))));
      const int qi = ((int)((long long)qd)) & 3;
      double s_, c_;
      if (qi == 0) { s_ = sr; c_ = cr; } else if (qi == 1) { s_ = cr; c_ = -sr; } else if (qi == 2) { s_ = -sr; c_ = -cr; } else { s_ = -cr; c_ = sr; }
      cs[idx] = (float)c_; sn[idx] = (float)s_;
    }
    return;
  }
  item -= PREP_ROPE;
  if (item < PREP_WSB) {
    const float* src = p.in[15];
    u16* dst = (u16*)(p.ws + OFF_WSB);
#pragma unroll
    for (int j = 0; j < 4; j++) {
      const int idx = item * 2048 + j * 512 + tid;
      const int t_ = (idx >> 7) & 127, s_ = idx & 127;
      dst[idx] = f2bf(s_ <= t_ ? src[idx] : 0.f);
    }
    return;
  }
  if (tid < 256) {
    const float* lbr = p.in[5];
    float v[4], m = -1e30f;
#pragma unroll
    for (int l = 0; l < 4; l++) { v[l] = lbr[l * 256 + tid]; m = fmaxf(m, v[l]); }
    float s = 0.f;
#pragma unroll
    for (int l = 0; l < 4; l++) { v[l] = __expf(v[l] - m); s += v[l]; }
    float* lb = (float*)(p.ws + OFF_LB);
    float cum = 0.f;
#pragma unroll
    for (int l = 0; l < 4; l++) { if (l > 0) cum += v[l] / s; lb[l * 256 + tid] = cum; }
  }
}

DI void ln_rows(const P& p, int layer, int mode, int item) {
  const int tid_ = tidx(); const int lane = tid_ & 63, wid = tid_ >> 6;
  const int row = (mode == 0) ? item * 8 + wid : item * 32 + wid * 4;
  const int b = row / S_;
  const float* mod = (const float*)(p.ws + OFF_MOD);
  u16* hb = (u16*)(p.ws + OFF_H) + (size_t)row * 1024;
  if (mode == 0) {
    const float* x = p.in[0] + (size_t)row * 1024;
    const float* md = mod + (size_t)(0 * 4 + b) * 6144;
#pragma unroll
    for (int i = 0; i < 4; i++) {
      const int col = i * 256 + lane * 4;
      const float4 xv = *(const float4*)(x + col);
      const float4 sh = *(const float4*)(md + col), sc = *(const float4*)(md + 1024 + col);
      uint2 pk; pk.x = pack2h(xv.x * (1.f + sc.x) + sh.x, xv.y * (1.f + sc.y) + sh.y); pk.y = pack2h(xv.z * (1.f + sc.z) + sh.z, xv.w * (1.f + sc.w) + sh.w);
      *(uint2*)(hb + col) = pk;
    }
    return;
  }
  constexpr int NR = 4;
  const float* lw = p.in[mode == 1 ? 21 : 23] + layer * 1024;
  const float* lbias = p.in[mode == 1 ? 22 : 24] + layer * 1024;
  const bool has_next = !(mode == 2 && layer == 3);
  const bool from_input = (layer == 0 && mode == 1);
  const u16* ybuf = (mode == 2 && layer == 3) ? (const u16*)(p.ws + OFF_YL) : (const u16*)p.out;
  const float* mdl = mod + (size_t)(layer * 4 + b) * 6144;
  const float* gvec = mdl + (mode == 1 ? 2 : 5) * 1024;
  const float* mprev = mdl + (mode == 1 ? 0 : 3) * 1024;
  const float* mdn = (mode == 1) ? mdl + 3 * 1024 : mod + (size_t)((layer + 1) * 4 + b) * 6144;
  float v[NR][16];
  float s[NR];
#pragma unroll
  for (int rr = 0; rr < NR; rr++) s[rr] = 0.f;
#pragma unroll
  for (int i = 0; i < 2; i++) {
    const int col = i * 512 + lane * 8;
    float gg[8], shv[8], isc[8];
    { const float4 a = *(const float4*)(gvec + col), c2 = *(const float4*)(gvec + col + 4);
      gg[0] = 1.f + a.x; gg[1] = 1.f + a.y; gg[2] = 1.f + a.z; gg[3] = 1.f + a.w; gg[4] = 1.f + c2.x; gg[5] = 1.f + c2.y; gg[6] = 1.f + c2.z; gg[7] = 1.f + c2.w; }
    if (!from_input) {
      const float4 a = *(const float4*)(mprev + col), c2 = *(const float4*)(mprev + col + 4);
      const float4 e = *(const float4*)(mprev + 1024 + col), f = *(const float4*)(mprev + 1024 + col + 4);
      shv[0] = a.x; shv[1] = a.y; shv[2] = a.z; shv[3] = a.w; shv[4] = c2.x; shv[5] = c2.y; shv[6] = c2.z; shv[7] = c2.w;
      isc[0] = 1.f / (1.f + e.x); isc[1] = 1.f / (1.f + e.y); isc[2] = 1.f / (1.f + e.z); isc[3] = 1.f / (1.f + e.w);
      isc[4] = 1.f / (1.f + f.x); isc[5] = 1.f / (1.f + f.y); isc[6] = 1.f / (1.f + f.z); isc[7] = 1.f / (1.f + f.w);
    } else {
#pragma unroll
      for (int j = 0; j < 8; j++) { shv[j] = 0.f; isc[j] = 1.f; }
    }
#pragma unroll
    for (int rr = 0; rr < NR; rr++) {
      const size_t r = (size_t)(row + rr);
      float xv[8], yv[8];
      if (from_input) {
        const float4 a = *(const float4*)(p.in[0] + r * 1024 + col), c2 = *(const float4*)(p.in[0] + r * 1024 + col + 4);
        xv[0] = a.x; xv[1] = a.y; xv[2] = a.z; xv[3] = a.w; xv[4] = c2.x; xv[5] = c2.y; xv[6] = c2.z; xv[7] = c2.w;
      } else {
        const uint4 hr = *(const uint4*)((const u16*)(p.ws + OFF_H) + r * 1024 + col);
        xv[0] = hlo2f(hr.x); xv[1] = hhi2f(hr.x); xv[2] = hlo2f(hr.y); xv[3] = hhi2f(hr.y);
        xv[4] = hlo2f(hr.z); xv[5] = hhi2f(hr.z); xv[6] = hlo2f(hr.w); xv[7] = hhi2f(hr.w);
#pragma unroll
        for (int j = 0; j < 8; j++) xv[j] = (xv[j] - shv[j]) * isc[j];
      }
      unpack8(*(const uint4*)(ybuf + r * 1024 + col), yv);
#pragma unroll
      for (int j = 0; j < 8; j++) { const float t_ = DN_ALPHA * xv[j] + gg[j] * yv[j]; v[rr][i * 8 + j] = t_; s[rr] += t_; }
    }
  }
  float mu[NR], rs[NR];
#pragma unroll
  for (int rr = 0; rr < NR; rr++) mu[rr] = s[rr];
#pragma unroll
  for (int o = 32; o > 0; o >>= 1) {
#pragma unroll
    for (int rr = 0; rr < NR; rr++) mu[rr] += __shfl_xor(mu[rr], o);
  }
#pragma unroll
  for (int rr = 0; rr < NR; rr++) {
    mu[rr] *= (1.f / 1024.f);
    float s2 = 0.f;
#pragma unroll
    for (int i = 0; i < 16; i++) { v[rr][i] -= mu[rr]; s2 += v[rr][i] * v[rr][i]; }
    rs[rr] = s2;
  }
#pragma unroll
  for (int o = 32; o > 0; o >>= 1) {
#pragma unroll
    for (int rr = 0; rr < NR; rr++) rs[rr] += __shfl_xor(rs[rr], o);
  }
#pragma unroll
  for (int rr = 0; rr < NR; rr++) rs[rr] = rsqrtf(rs[rr] * (1.f / 1024.f) + 1e-5f);
#pragma unroll
  for (int i = 0; i < 2; i++) {
    const int col = i * 512 + lane * 8;
    float wv[8], bv[8], shn[8], scn[8];
    { const float4 a = *(const float4*)(lw + col), c2 = *(const float4*)(lw + col + 4), e = *(const float4*)(lbias + col), f = *(const float4*)(lbias + col + 4);
      wv[0] = a.x; wv[1] = a.y; wv[2] = a.z; wv[3] = a.w; wv[4] = c2.x; wv[5] = c2.y; wv[6] = c2.z; wv[7] = c2.w;
      bv[0] = e.x; bv[1] = e.y; bv[2] = e.z; bv[3] = e.w; bv[4] = f.x; bv[5] = f.y; bv[6] = f.z; bv[7] = f.w; }
    if (has_next) {
      const float4 a = *(const float4*)(mdn + col), c2 = *(const float4*)(mdn + col + 4), e = *(const float4*)(mdn + 1024 + col), f = *(const float4*)(mdn + 1024 + col + 4);
      shn[0] = a.x; shn[1] = a.y; shn[2] = a.z; shn[3] = a.w; shn[4] = c2.x; shn[5] = c2.y; shn[6] = c2.z; shn[7] = c2.w;
      scn[0] = 1.f + e.x; scn[1] = 1.f + e.y; scn[2] = 1.f + e.z; scn[3] = 1.f + e.w; scn[4] = 1.f + f.x; scn[5] = 1.f + f.y; scn[6] = 1.f + f.z; scn[7] = 1.f + f.w;
    } else {
#pragma unroll
      for (int j = 0; j < 8; j++) { shn[j] = 0.f; scn[j] = 1.f; }
    }
#pragma unroll
    for (int rr = 0; rr < NR; rr++) {
      const size_t r = (size_t)(row + rr);
      float o[8];
#pragma unroll
      for (int j = 0; j < 8; j++) o[j] = v[rr][i * 8 + j] * rs[rr] * wv[j] + bv[j];
      if (has_next) {
        uint4 pk;
        pk.x = pack2h(o[0] * scn[0] + shn[0], o[1] * scn[1] + shn[1]); pk.y = pack2h(o[2] * scn[2] + shn[2], o[3] * scn[3] + shn[3]);
        pk.z = pack2h(o[4] * scn[4] + shn[4], o[5] * scn[5] + shn[5]); pk.w = pack2h(o[6] * scn[6] + shn[6], o[7] * scn[7] + shn[7]);
        *(uint4*)((u16*)(p.ws + OFF_H) + r * 1024 + col) = pk;
      } else {
        *(float4*)(p.out + r * 1024 + col) = make_float4(o[0], o[1], o[2], o[3]);
        *(float4*)(p.out + r * 1024 + col + 4) = make_float4(o[4], o[5], o[6], o[7]);
      }
    }
  }
}

DI void hgrn_item(const P& p, int layer, int item, int mode, char* smem) {
  const int hh = item & 3, c = (item >> 2) & 127, b = item >> 9;
  const int bh = b * 4 + hh;
  const int tid = tidx();
  float* Bf = (float*)smem;
  float* A1 = Bf + 4096;
  float* At = A1 + 4160;
  float* A2 = At + 4160;
  float* Vs = A2 + 4096;
  float* Sp = Vs + 4096;
  float* seg = Sp + 4096;
  constexpr int HK = 72;
  u16* QdB = (u16*)(A1);
  u16* KdB = QdB + 64 * HK;
  u16* AtB = KdB + 64 * HK;
  u16* VtB = AtB + 64 * HK;
  u16* SpT = VtB + 64 * HK;
  const u16* pr = (const u16*)(p.ws + OFF_BIG) + (size_t)(b * S_ + c * 64) * PW + hh * 64;
  const float* lbp = (const float*)(p.ws + OFF_LB) + layer * 256 + hh * 64;
  float* stp = (float*)(p.ws + OFF_ST) + (size_t)(bh * 128 + c) * 4096;
  const int s = tid >> 3, k8 = (tid & 7) * 8;
  float z[8];
  {
    float vv[8];
    unpack8(*(const uint4*)(pr + (size_t)s * PW + 256 + k8), z);
    unpack8(*(const uint4*)(pr + (size_t)s * PW + 512 + k8), vv);
#pragma unroll
    for (int j = 0; j < 8; j++) {
      const float lb = lbp[k8 + j];
      const float f = lb + (1.f - lb) * sigm(z[j]);
      Bf[s * 64 + k8 + j] = logf(fmaxf(f, 1e-30f));
      VtB[(k8 + j) * HK + s] = f2bf(vv[j]);
    }
  }
  __syncthreads();
  {
    const int k = tid & 63, sg = tid >> 6;
    float run = 0.f, loc[8];
#pragma unroll
    for (int i = 0; i < 8; i++) { run += Bf[(sg * 8 + i) * 64 + k]; loc[i] = run; }
    seg[sg * 64 + k] = run;
    __syncthreads();
    float pre = 0.f;
    for (int j = 0; j < sg; j++) pre += seg[j * 64 + k];
#pragma unroll
    for (int i = 0; i < 8; i++) Bf[(sg * 8 + i) * 64 + k] = loc[i] + pre;
  }
  __syncthreads();
  if (mode == 0) {
    u16* KdT = KdB;
#pragma unroll
    for (int j = 0; j < 8; j++) {
      const int k = k8 + j;
      const float lb = lbp[k];
      const float kk = (1.f - lb) * sigm(-z[j]);
      KdT[k * HK + s] = f2bf(kk * __expf(Bf[63 * 64 + k] - Bf[s * 64 + k]));
    }
    __syncthreads();
    const int lane = tid & 63, wid = tid >> 6, m = lane & 15, lg = lane >> 4;
    const int kt = wid >> 1;
#pragma unroll
    for (int q = 0; q < 2; q++) {
      const int vt = (wid & 1) * 2 + q;
      f32x4 acc = {0.f, 0.f, 0.f, 0.f};
#pragma unroll
      for (int ks = 0; ks < 2; ks++) {
        const bf16x8 av = *(const bf16x8*)(VtB + (16 * vt + m) * HK + 32 * ks + 8 * lg);
        const bf16x8 bk = *(const bf16x8*)(KdT + (16 * kt + m) * HK + 32 * ks + 8 * lg);
        acc = mfma16(av, bk, acc);
      }
      *(float4*)(stp + (16 * kt + m) * 64 + 16 * vt + 4 * lg) = make_float4(acc[0], acc[1], acc[2], acc[3]);
    }
    if (tid < 64) ((float*)(p.ws + OFF_DEC))[(size_t)(bh * 128 + c) * 64 + tid] = __expf(Bf[63 * 64 + tid]);
    __syncthreads();
    return;
  }
  {
    float qv[8];
    unpack8(*(const uint4*)(pr + (size_t)s * PW + k8), qv);
    float qd[8], kd[8];
#pragma unroll
    for (int j = 0; j < 8; j++) {
      const int k = k8 + j;
      const float lb = lbp[k];
      const float bm = Bf[31 * 64 + k], bb = Bf[s * 64 + k];
      qd[j] = silu(qv[j]) * __expf(bb - bm);
      kd[j] = (1.f - lb) * sigm(-z[j]) * __expf(bm - bb);
    }
    uint4 pq, pk_;
    pq.x = pack2(qd[0], qd[1]); pq.y = pack2(qd[2], qd[3]); pq.z = pack2(qd[4], qd[5]); pq.w = pack2(qd[6], qd[7]);
    pk_.x = pack2(kd[0], kd[1]); pk_.y = pack2(kd[2], kd[3]); pk_.z = pack2(kd[4], kd[5]); pk_.w = pack2(kd[6], kd[7]);
    *(uint4*)(QdB + s * HK + k8) = pq;
    *(uint4*)(KdB + s * HK + k8) = pk_;
    const int k = tid >> 3, v0 = (tid & 7) * 8;
    const float e = __expf(Bf[31 * 64 + k]);
    const float4 sa = *(const float4*)(stp + k * 64 + v0), sb = *(const float4*)(stp + k * 64 + v0 + 4);
    const float sv[8] = {sa.x, sa.y, sa.z, sa.w, sb.x, sb.y, sb.z, sb.w};
#pragma unroll
    for (int i = 0; i < 8; i++) SpT[(v0 + i) * HK + k] = f2bf(sv[i] * e);
  }
  __syncthreads();
  const int lane = tid & 63, wid = tid >> 6, m = lane & 15, lg = lane >> 4;
  {
    const int mt = wid >> 1;
#pragma unroll
    for (int q = 0; q < 2; q++) {
      const int nt = (wid & 1) * 2 + q;
      f32x4 acc = {0.f, 0.f, 0.f, 0.f};
#pragma unroll
      for (int ks = 0; ks < 2; ks++) {
        const bf16x8 af = *(const bf16x8*)(KdB + (16 * nt + m) * HK + 32 * ks + 8 * lg);
        const bf16x8 bfr = *(const bf16x8*)(QdB + (16 * mt + m) * HK + 32 * ks + 8 * lg);
        acc = mfma16(af, bfr, acc);
      }
      const int t_ = 16 * mt + m, s0 = 16 * nt + 4 * lg;
      uint2 pk;
      pk.x = pack2(s0 + 0 <= t_ ? acc[0] : 0.f, s0 + 1 <= t_ ? acc[1] : 0.f);
      pk.y = pack2(s0 + 2 <= t_ ? acc[2] : 0.f, s0 + 3 <= t_ ? acc[3] : 0.f);
      *(uint2*)(AtB + t_ * HK + s0) = pk;
    }
  }
  __syncthreads();
  if (wid < 4) {
    const int mt = wid;
    f32x4 acc[4];
#pragma unroll
    for (int nt = 0; nt < 4; nt++) acc[nt] = (f32x4){0.f, 0.f, 0.f, 0.f};
#pragma unroll
    for (int ks = 0; ks < 2; ks++) {
      const bf16x8 ba = *(const bf16x8*)(AtB + (16 * mt + m) * HK + 32 * ks + 8 * lg);
      const bf16x8 bq = *(const bf16x8*)(QdB + (16 * mt + m) * HK + 32 * ks + 8 * lg);
#pragma unroll
      for (int nt = 0; nt < 4; nt++) {
        const bf16x8 av = *(const bf16x8*)(VtB + (16 * nt + m) * HK + 32 * ks + 8 * lg);
        const bf16x8 as_ = *(const bf16x8*)(SpT + (16 * nt + m) * HK + 32 * ks + 8 * lg);
        acc[nt] = mfma16(av, ba, acc[nt]);
        acc[nt] = mfma16(as_, bq, acc[nt]);
      }
    }
    float ssq = 0.f;
#pragma unroll
    for (int nt = 0; nt < 4; nt++) ssq += acc[nt][0] * acc[nt][0] + acc[nt][1] * acc[nt][1] + acc[nt][2] * acc[nt][2] + acc[nt][3] * acc[nt][3];
    ssq += __shfl_xor(ssq, 16); ssq += __shfl_xor(ssq, 32);
    const float rn = rsqrtf(ssq * (1.f / 64.f) + 1e-6f);
    const int t_ = 16 * mt + m;
    const float* nw = p.in[6] + layer * 64;
#pragma unroll
    for (int nt = 0; nt < 4; nt++) {
      const int v0 = 16 * nt + 4 * lg;
      const uint2 gr = *(const uint2*)(pr + (size_t)t_ * PW + 768 + v0);
      const float4 n4 = *(const float4*)(nw + v0);
      uint2 pk;
      pk.x = pack2(acc[nt][0] * rn * n4.x * silu(lo2f(gr.x)), acc[nt][1] * rn * n4.y * silu(hi2f(gr.x)));
      pk.y = pack2(acc[nt][2] * rn * n4.z * silu(lo2f(gr.y)), acc[nt][3] * rn * n4.w * silu(hi2f(gr.y)));
      *(uint2*)((u16*)(p.ws + OFF_MIX) + (size_t)(b * S_ + c * 64 + t_) * 1024 + hh * 64 + v0) = pk;
    }
  }
  __syncthreads();
}

DI void scan_item(const P& p, int item) {
  const int tid = tidx();
  if (tid >= 256) return;
  const int gid = item * 256 + tid;
  const int bh = gid >> 12, e = gid & 4095;
  float* st = (float*)(p.ws + OFF_ST) + (size_t)bh * 128 * 4096 + e;
  const float* dc = (const float*)(p.ws + OFF_DEC) + (size_t)bh * 128 * 64 + (e >> 6);
  float carry = 0.f;
  for (int c0 = 0; c0 < 128; c0 += 16) {
    float tmp[16], d[16];
#pragma unroll
    for (int j = 0; j < 16; j++) { tmp[j] = st[(size_t)(c0 + j) * 4096]; d[j] = dc[(c0 + j) * 64]; }
#pragma unroll
    for (int j = 0; j < 16; j++) { st[(size_t)(c0 + j) * 4096] = carry; carry = d[j] * carry + tmp[j]; }
  }
}

DI void gmlp_item(const P& p, int layer, int item, char* smem) {
  constexpr int KS = 136;
  const int g = item & 3, ch = (item >> 2) & 63, b = item >> 8;
  const int tid = tidx(), lane = tid & 63, wid = tid >> 6;
  u16* VnT = (u16*)smem;
  const size_t tok0 = (size_t)b * S_ + ch * 128;
  const u16* proj = (const u16*)(p.ws + OFF_BIG);
  const float* nw = p.in[13] + layer * 256;
  const float* nb = p.in[14] + layer * 256;
  for (int t4b = 0; t4b < 16; t4b += 4) {
    float v[4][4], mu[4], rs[4];
#pragma unroll
    for (int q = 0; q < 4; q++) {
      const int tl = wid * 16 + t4b + q;
      const uint2 raw = *(const uint2*)(proj + (tok0 + tl) * PW + 2584 + lane * 4);
      v[q][0] = gelu_t(lo2f(raw.x)); v[q][1] = gelu_t(hi2f(raw.x)); v[q][2] = gelu_t(lo2f(raw.y)); v[q][3] = gelu_t(hi2f(raw.y));
    }
#pragma unroll
    for (int q = 0; q < 4; q++) mu[q] = v[q][0] + v[q][1] + v[q][2] + v[q][3];
#pragma unroll
    for (int o = 32; o > 0; o >>= 1) {
#pragma unroll
      for (int q = 0; q < 4; q++) mu[q] += __shfl_xor(mu[q], o);
    }
#pragma unroll
    for (int q = 0; q < 4; q++) {
      mu[q] *= (1.f / 256.f);
      float d2 = 0.f;
#pragma unroll
      for (int j = 0; j < 4; j++) { v[q][j] -= mu[q]; d2 += v[q][j] * v[q][j]; }
      rs[q] = d2;
    }
#pragma unroll
    for (int o = 32; o > 0; o >>= 1) {
#pragma unroll
      for (int q = 0; q < 4; q++) rs[q] += __shfl_xor(rs[q], o);
    }
    if ((lane >> 4) == g) {
#pragma unroll
      for (int q = 0; q < 4; q++) {
        const int tl = wid * 16 + t4b + q;
        const float r = rsqrtf(rs[q] * (1.f / 256.f) + 1e-5f);
#pragma unroll
        for (int j = 0; j < 4; j++) { const int cch = lane * 4 + j; VnT[((lane & 15) * 4 + j) * KS + tl] = f2bf(v[q][j] * r * nw[cch] + nb[cch]); }
      }
    }
  }
  __syncthreads();
  const int tw = (wid < 4) ? wid : 11 - wid;
  const int m = lane & 15, hh = lane >> 4;
  const u16* wrow = (const u16*)(p.ws + OFF_WSB) + ((size_t)(layer * 4 + g) * 128 + 16 * tw + m) * 128 + 8 * hh;
  f32x4 acc[4];
#pragma unroll
  for (int nt = 0; nt < 4; nt++) acc[nt] = (f32x4){0.f, 0.f, 0.f, 0.f};
  const int nks = ((16 * tw + 15) >> 5) + 1;
  for (int ks = 0; ks < nks; ks++) {
    const bf16x8 wf = *(const bf16x8*)(wrow + 32 * ks);
#pragma unroll
    for (int nt = 0; nt < 4; nt++) {
      const bf16x8 vfr = *(const bf16x8*)(VnT + (16 * nt + m) * KS + 32 * ks + 8 * hh);
      acc[nt] = mfma16(vfr, wf, acc[nt]);
    }
  }
  {
    const int t_ = 16 * tw + m;
    const size_t tok = tok0 + t_;
    const float bsv = p.in[16][(size_t)(layer * 4 + g) * 128 + t_];
#pragma unroll
    for (int nt = 0; nt < 4; nt++) {
      const int c0 = 16 * nt + 4 * hh;
      const uint2 ur = *(const uint2*)(proj + tok * PW + 2328 + g * 64 + c0);
      const float u0 = gelu_t(lo2f(ur.x)), u1 = gelu_t(hi2f(ur.x)), u2 = gelu_t(lo2f(ur.y)), u3 = gelu_t(hi2f(ur.y));
      uint2 pk; pk.x = pack2(u0 * (acc[nt][0] + bsv), u1 * (acc[nt][1] + bsv)); pk.y = pack2(u2 * (acc[nt][2] + bsv), u3 * (acc[nt][3] + bsv));
      *(uint2*)((u16*)(p.ws + OFF_MIX) + tok * 1024 + 768 + g * 64 + c0) = pk;
    }
  }
  __syncthreads();
}

DI void qk_block(const u16* __restrict__ Kb, int ldk, bf16x8 q0, bf16x8 q1, f32x4 (&st)[4], int lane) {
  const int m = lane & 15, hh = lane >> 4;
#pragma unroll
  for (int i = 0; i < 4; i++) {
    const int key = 32 * (i >> 1) + 8 * (m >> 2) + 4 * (i & 1) + (m & 3);
    const u16* kp = Kb + (size_t)key * ldk + 8 * hh;
    const bf16x8 k0 = *(const bf16x8*)kp, k1 = *(const bf16x8*)(kp + 32);
    f32x4 z = {0.f, 0.f, 0.f, 0.f};
    z = mfma16(k0, q0, z);
    st[i] = mfma16(k1, q1, z);
  }
}
DI void pv_block(const u16* __restrict__ VTb, int ldv, bf16x8 p0, bf16x8 p1, f32x4 (&o)[4], int lane) {
  const int m = lane & 15, hh = lane >> 4;
#pragma unroll
  for (int mt = 0; mt < 4; mt++) {
    const u16* vp = VTb + (size_t)(mt * 16 + m) * ldv + 8 * hh;
    const bf16x8 v0 = *(const bf16x8*)vp, v1 = *(const bf16x8*)(vp + 32);
    o[mt] = mfma16(v0, p0, o[mt]);
    o[mt] = mfma16(v1, p1, o[mt]);
  }
}
DI bf16x8 packp(const f32x4& a, const f32x4& b) {
  typedef __attribute__((ext_vector_type(4))) unsigned u32x4_t;
  u32x4_t v = {pack2(a[0], a[1]), pack2(a[2], a[3]), pack2(b[0], b[1]), pack2(b[2], b[3])};
  return __builtin_bit_cast(bf16x8, v);
}
template <class MF>
DI void attn_block(const u16* Kb, int ldk, const u16* VTb, int ldv, bf16x8 q0, bf16x8 q1, float& m_run, float& l_run, f32x4 (&o)[4], MF mask, int lane) {
  f32x4 st[4];
  qk_block(Kb, ldk, q0, q1, st, lane);
  const int h = lane >> 4;
  float bm = NEGF;
#pragma unroll
  for (int i = 0; i < 4; i++)
#pragma unroll
    for (int r = 0; r < 4; r++) {
      const int kk = 32 * (i >> 1) + 8 * h + 4 * (i & 1) + r;
      const float v = mask(kk) ? st[i][r] : NEGF;
      st[i][r] = v; bm = fmaxf(bm, v);
    }
  bm = fmaxf(bm, __shfl_xor(bm, 16)); bm = fmaxf(bm, __shfl_xor(bm, 32));
  const float mn = fmaxf(m_run, bm);
  const float sc = __expf(m_run - mn);
  float ps = 0.f;
#pragma unroll
  for (int i = 0; i < 4; i++)
#pragma unroll
    for (int r = 0; r < 4; r++) {
      const float pv = (st[i][r] > -1e29f) ? __expf(st[i][r] - mn) : 0.f;
      st[i][r] = pv; ps += pv;
    }
  l_run = l_run * sc + ps; m_run = mn;
#pragma unroll
  for (int mt = 0; mt < 4; mt++) { o[mt][0] *= sc; o[mt][1] *= sc; o[mt][2] *= sc; o[mt][3] *= sc; }
  pv_block(VTb, ldv, packp(st[0], st[1]), packp(st[2], st[3]), o, lane);
}
DI unsigned long long rfl64(unsigned long long v) {
  unsigned lo = __builtin_amdgcn_readfirstlane((unsigned)v), hi = __builtin_amdgcn_readfirstlane((unsigned)(v >> 32));
  return ((unsigned long long)hi << 32) | lo;
}

DI void nsa_item(const P& p, int item, char* smem) {
  const int tid = tidx(), lane = tid & 63, wid = tid >> 6;
  const int bh = item & 7, qt = 255 - (item >> 3);
  const int b = bh >> 1, hk = bh & 1;
  const int t0 = qt * 32 + wid * 4;
  float* pg = (float*)smem + wid * (2048 + 128);
  float* impb = pg + 2048;
  const int col = lane & 15, h = lane >> 4, qi = col >> 2, g = col & 3;
  const int t = t0 + qi;
  const u16* proj = (const u16*)(p.ws + OFF_BIG);
  const size_t rowq = (size_t)(b * S_ + t) * PW;
  const bf16x8 q0 = *(const bf16x8*)(proj + rowq + 1024 + (hk * 4 + g) * 64 + 8 * h);
  const bf16x8 q1 = *(const bf16x8*)(proj + rowq + 1024 + (hk * 4 + g) * 64 + 32 + 8 * h);
  const float gt0 = sigm(bf2f(proj[rowq + 2304 + hk * 12 + g * 3 + 0]));
  const float gt1 = sigm(bf2f(proj[rowq + 2304 + hk * 12 + g * 3 + 1]));
  const float gt2 = sigm(bf2f(proj[rowq + 2304 + hk * 12 + g * 3 + 2]));
  f32x4 outa[4];
#pragma unroll
  for (int mt = 0; mt < 4; mt++) outa[mt] = (f32x4){0.f, 0.f, 0.f, 0.f};
  const int tb = t0 >> 6;

  for (int i = lane; i < 2048; i += 64) pg[i] = 0.f;
  const int nmaxw = (t0 + 3 >= 31) ? ((t0 + 3 - 31) >> 4) : -1;
  if (nmaxw >= 0) {
    const u16* kcb = (const u16*)(p.ws + OFF_KC) + (size_t)bh * 512 * 64;
    const u16* vcb = (const u16*)(p.ws + OFF_VCT) + (size_t)bh * 64 * 512;
    const int nblk = (nmaxw >> 6) + 1;
    const int nqv = (t >= 31) ? ((t - 31) >> 4) : -1;
    float m_run = NEGF, l_run = 0.f;
    for (int blk = 0; blk < nblk; blk++) {
      f32x4 st[4];
      qk_block(kcb + (size_t)blk * 64 * 64, 64, q0, q1, st, lane);
      float bm = NEGF;
#pragma unroll
      for (int i = 0; i < 4; i++)
#pragma unroll
        for (int r = 0; r < 4; r++) {
          const int n = blk * 64 + 32 * (i >> 1) + 8 * h + 4 * (i & 1) + r;
          const float v = (n <= nqv) ? st[i][r] : NEGF;
          st[i][r] = v; bm = fmaxf(bm, v);
        }
      bm = fmaxf(bm, __shfl_xor(bm, 16)); bm = fmaxf(bm, __shfl_xor(bm, 32));
      const float mn = fmaxf(m_run, bm);
      float ps = 0.f;
#pragma unroll
      for (int i = 0; i < 4; i++)
#pragma unroll
        for (int r = 0; r < 4; r++) ps += (st[i][r] > -1e29f) ? __expf(st[i][r] - mn) : 0.f;
      l_run = l_run * __expf(m_run - mn) + ps; m_run = mn;
    }
    float lt = l_run; lt += __shfl_xor(lt, 16); lt += __shfl_xor(lt, 32);
    const float inv = lt > 0.f ? 1.f / lt : 0.f;
    f32x4 o[4];
#pragma unroll
    for (int mt = 0; mt < 4; mt++) o[mt] = (f32x4){0.f, 0.f, 0.f, 0.f};
    for (int blk = 0; blk < nblk; blk++) {
      f32x4 st[4];
      qk_block(kcb + (size_t)blk * 64 * 64, 64, q0, q1, st, lane);
#pragma unroll
      for (int i = 0; i < 4; i++)
#pragma unroll
        for (int r = 0; r < 4; r++) {
          const int n = blk * 64 + 32 * (i >> 1) + 8 * h + 4 * (i & 1) + r;
          const float pv = (n <= nqv) ? __expf(st[i][r] - m_run) * inv : 0.f;
          st[i][r] = pv;
          float psum = pv; psum += __shfl_xor(psum, 1); psum += __shfl_xor(psum, 2);
          if (g == 0) pg[qi * 512 + n] = psum;
        }
      pv_block(vcb + blk * 64, 512, packp(st[0], st[1]), packp(st[2], st[3]), o, lane);
    }
#pragma unroll
    for (int mt = 0; mt < 4; mt++) { outa[mt][0] += gt0 * o[mt][0]; outa[mt][1] += gt0 * o[mt][1]; outa[mt][2] += gt0 * o[mt][2]; outa[mt][3] += gt0 * o[mt][3]; }
  }
  __builtin_amdgcn_fence(__ATOMIC_RELEASE, "wavefront");
  asm volatile("s_waitcnt lgkmcnt(0)" ::: "memory");

  unsigned long long mylo = 0, myhi = 0, ulo = 0, uhi = 0;
  if (tb <= 15) { mylo = (2ull << tb) - 1ull; ulo = mylo; }
  else {
    for (int qq = 0; qq < 4; qq++) {
      const float* pgq = pg + qq * 512;
      const int j0 = lane, j1 = lane + 64;
      const bool c0ok = (j0 >= 1 && j0 <= tb - 2), c1ok = (j1 <= tb - 2);
      float v0 = -1.f, v1 = -1.f;
      if (c0ok) v0 = pgq[4 * j0 - 1] + pgq[4 * j0] + pgq[4 * j0 + 1] + pgq[4 * j0 + 2] + pgq[4 * j0 + 3];
      if (c1ok) v1 = pgq[4 * j1 - 1] + pgq[4 * j1] + pgq[4 * j1 + 1] + pgq[4 * j1 + 2] + pgq[4 * j1 + 3];
      asm volatile("s_waitcnt lgkmcnt(0)" ::: "memory");
      impb[j0] = v0; impb[j1] = v1;
      asm volatile("s_waitcnt lgkmcnt(0)" ::: "memory");
      int c0 = 0, c1 = 0;
      for (int jj = 1; jj <= tb - 2; jj++) {
        const float vv = impb[jj];
        c0 += ((vv > v0) || (vv == v0 && jj < j0)) ? 1 : 0;
        c1 += ((vv > v1) || (vv == v1 && jj < j1)) ? 1 : 0;
      }
      const bool s0 = (c0ok && c0 < 13) || j0 == 0 || j0 == tb || j0 == tb - 1;
      const bool s1 = (c1ok && c1 < 13) || j1 == tb || j1 == tb - 1;
      const unsigned long long blo = __ballot(s0), bhi_ = __ballot(s1);
      if (qi == qq) { mylo = blo; myhi = bhi_; }
      ulo |= blo; uhi |= bhi_;
      asm volatile("s_waitcnt lgkmcnt(0)" ::: "memory");
    }
  }

  {
    const u16* ksb = proj + (size_t)b * S_ * PW + 1792 + hk * 64;
    const u16* vsb = (const u16*)(p.ws + OFF_VTS) + (size_t)bh * 64 * S_;
    float m_run = NEGF, l_run = 0.f;
    f32x4 o[4];
#pragma unroll
    for (int mt = 0; mt < 4; mt++) o[mt] = (f32x4){0.f, 0.f, 0.f, 0.f};
    for (int half = 0; half < 2; half++) {
      unsigned long long um = rfl64(half ? uhi : ulo);
      const unsigned long long mym = half ? myhi : mylo;
      while (um) {
        const int bl = __builtin_ctzll(um); um &= um - 1ull;
        const int blk = bl + half * 64;
        const bool selq = (mym >> bl) & 1ull;
        const int kbase = blk * 64;
        attn_block(ksb + (size_t)kbase * PW, PW, vsb + kbase, S_, q0, q1, m_run, l_run, o,
                   [&](int kk) { return selq && (kbase + kk <= t); }, lane);
      }
    }
    float lt = l_run; lt += __shfl_xor(lt, 16); lt += __shfl_xor(lt, 32);
    const float w = lt > 0.f ? gt1 / lt : 0.f;
#pragma unroll
    for (int mt = 0; mt < 4; mt++) { outa[mt][0] += w * o[mt][0]; outa[mt][1] += w * o[mt][1]; outa[mt][2] += w * o[mt][2]; outa[mt][3] += w * o[mt][3]; }
  }
  {
    const u16* kwb = proj + (size_t)b * S_ * PW + 2048 + hk * 64;
    const u16* vwb = (const u16*)(p.ws + OFF_VTW) + (size_t)bh * 64 * S_;
    float m_run = NEGF, l_run = 0.f;
    f32x4 o[4];
#pragma unroll
    for (int mt = 0; mt < 4; mt++) o[mt] = (f32x4){0.f, 0.f, 0.f, 0.f};
    const int wb0 = (t0 >= 511) ? ((t0 - 511) >> 6) : 0;
    for (int blk = wb0; blk <= tb; blk++) {
      const int kbase = blk * 64;
      attn_block(kwb + (size_t)kbase * PW, PW, vwb + kbase, S_, q0, q1, m_run, l_run, o,
                 [&](int kk) { const int kp = kbase + kk; return (kp <= t) && (kp > t - 512); }, lane);
    }
    float lt = l_run; lt += __shfl_xor(lt, 16); lt += __shfl_xor(lt, 32);
    const float w = lt > 0.f ? gt2 / lt : 0.f;
#pragma unroll
    for (int mt = 0; mt < 4; mt++) { outa[mt][0] += w * o[mt][0]; outa[mt][1] += w * o[mt][1]; outa[mt][2] += w * o[mt][2]; outa[mt][3] += w * o[mt][3]; }
  }
  u16* mo = (u16*)(p.ws + OFF_MIX) + (size_t)(b * S_ + t) * 1024 + 256 + (hk * 4 + g) * 64 + 4 * h;
#pragma unroll
  for (int mt = 0; mt < 4; mt++) {
    uint2 pk; pk.x = pack2(outa[mt][0], outa[mt][1]); pk.y = pack2(outa[mt][2], outa[mt][3]);
    *(uint2*)(mo + 16 * mt) = pk;
  }
  __syncthreads();
}


constexpr int KROW = 80;
constexpr int STG = 64 * KROW;
DI void qk_lds(const u16* Ks, bf16x8 q0, bf16x8 q1, f32x4 (&st)[4], int lane) {
  const u16* kp = Ks + (lane & 15) * KROW + 8 * (lane >> 4);
#pragma unroll
  for (int i = 0; i < 4; i++) {
    const bf16x8 k0 = *(const bf16x8*)(kp + i * 16 * KROW), k1 = *(const bf16x8*)(kp + i * 16 * KROW + 32);
    f32x4 z = {0.f, 0.f, 0.f, 0.f};
    z = mfma16(k0, q0, z);
    st[i] = mfma16(k1, q1, z);
  }
}
DI void pv_lds(const u16* Vs, bf16x8 p0, bf16x8 p1, f32x4 (&o)[4], int lane) {
  const u16* vp = Vs + (lane & 15) * KROW + 8 * (lane >> 4);
#pragma unroll
  for (int mt = 0; mt < 4; mt++) {
    const bf16x8 v0 = *(const bf16x8*)(vp + mt * 16 * KROW), v1 = *(const bf16x8*)(vp + mt * 16 * KROW + 32);
    o[mt] = mfma16(v0, p0, o[mt]);
    o[mt] = mfma16(v1, p1, o[mt]);
  }
}
constexpr float LOG2E = 1.4426950408889634f;
DI float xmax16(float v) { const unsigned u = __float_as_uint(v); auto r = __builtin_amdgcn_permlane16_swap(u, u, false, false); return fmaxf(__uint_as_float(r[0]), __uint_as_float(r[1])); }
DI float xmax32(float v) { const unsigned u = __float_as_uint(v); auto r = __builtin_amdgcn_permlane32_swap(u, u, false, false); return fmaxf(__uint_as_float(r[0]), __uint_as_float(r[1])); }
template <int MODE, class MF>
DI void attn_lds(const u16* Ks, const u16* Vs, bf16x8 q0, bf16x8 q1, float& m_run, float& l_run, f32x4 (&o)[4], MF mask, bool selq, int lane) {
  f32x4 st[4];
  bf16x8 kf[8], vf[8];
  {
    const u16* kp = Ks + (lane & 15) * KROW + 8 * (lane >> 4);
    const u16* vp = Vs + (lane & 15) * KROW + 8 * (lane >> 4);
#pragma unroll
    for (int i = 0; i < 4; i++) { kf[2 * i] = *(const bf16x8*)(kp + i * 16 * KROW); kf[2 * i + 1] = *(const bf16x8*)(kp + i * 16 * KROW + 32); }
#pragma unroll
    for (int i = 0; i < 4; i++) { vf[2 * i] = *(const bf16x8*)(vp + i * 16 * KROW); vf[2 * i + 1] = *(const bf16x8*)(vp + i * 16 * KROW + 32); }
  }
  __builtin_amdgcn_sched_barrier(0);
#pragma unroll
  for (int i = 0; i < 4; i++) {
    f32x4 z = {0.f, 0.f, 0.f, 0.f};
    z = mfma16(kf[2 * i], q0, z);
    st[i] = mfma16(kf[2 * i + 1], q1, z);
  }
  const int h = lane >> 4;
  float bm = NEGF;
#pragma unroll
  for (int i = 0; i < 4; i++)
#pragma unroll
    for (int r = 0; r < 4; r++) {
      if (MODE == 2) {
        const int kk = 32 * (i >> 1) + 8 * h + 4 * (i & 1) + r;
        st[i][r] = mask(kk) ? st[i][r] : NEGF;
      }
      bm = fmaxf(bm, st[i][r]);
    }
  if (MODE == 1) bm = selq ? bm : NEGF;
  bm = xmax32(xmax16(bm));
  const float mn = fmaxf(m_run, bm);
  const float sc = __builtin_amdgcn_exp2f((m_run - mn) * LOG2E);
  float mns = fmaxf(mn, -1e20f) * LOG2E;
  if (MODE == 1) mns = selq ? mns : 1e30f;
  float ps = 0.f;
#pragma unroll
  for (int i = 0; i < 4; i++)
#pragma unroll
    for (int r = 0; r < 4; r++) {
      const float pv = __builtin_amdgcn_exp2f(fmaf(st[i][r], LOG2E, -mns));
      st[i][r] = pv; ps += pv;
    }
  l_run = l_run * sc + ps; m_run = mn;
#pragma unroll
  for (int mt = 0; mt < 4; mt++) { o[mt][0] *= sc; o[mt][1] *= sc; o[mt][2] *= sc; o[mt][3] *= sc; }
  const bf16x8 p0 = packp(st[0], st[1]), p1 = packp(st[2], st[3]);
#pragma unroll
  for (int mt = 0; mt < 4; mt++) {
    o[mt] = mfma16(vf[2 * mt], p0, o[mt]);
    o[mt] = mfma16(vf[2 * mt + 1], p1, o[mt]);
  }
}

DI void nsa_item2(const P& p, int item, char* smem) {
  const int tid = tidx(), lane = tid & 63, wid = tid >> 6;
  const int bh = item & 7, qt = 255 - (item >> 3);
  const int b = bh >> 1, hk = bh & 1;
  const int t0 = qt * 32 + wid * 4;
  u16* stg = (u16*)smem;
  float* impw = (float*)(smem + 2 * 2 * 2 * STG * 2) + wid * 1024;
  const int col = lane & 15, h = lane >> 4, qi = col >> 2, g = col & 3;
  const int t = t0 + qi;
  const u16* proj = (const u16*)(p.ws + OFF_BIG);
  const size_t rowq = (size_t)(b * S_ + t) * PW;
  const bf16x8 q0 = *(const bf16x8*)(proj + rowq + 1024 + (hk * 4 + g) * 64 + 8 * h);
  const bf16x8 q1 = *(const bf16x8*)(proj + rowq + 1024 + (hk * 4 + g) * 64 + 32 + 8 * h);
  const float gt0 = sigm(bf2f(proj[rowq + 2304 + hk * 12 + g * 3 + 0]));
  const float gt1 = sigm(bf2f(proj[rowq + 2304 + hk * 12 + g * 3 + 1]));
  const float gt2 = sigm(bf2f(proj[rowq + 2304 + hk * 12 + g * 3 + 2]));
  f32x4 outa[4], o[4];
#pragma unroll
  for (int mt = 0; mt < 4; mt++) { outa[mt] = (f32x4){0.f, 0.f, 0.f, 0.f}; o[mt] = (f32x4){0.f, 0.f, 0.f, 0.f}; }
  const int tb = qt >> 1;
  const int nc = (qt >> 5) + 1;
  const int wb0 = (qt * 32 >= 511) ? ((qt * 32 - 511) >> 6) : 0;
  const int nw = tb - wb0 + 1;
  const int U = 2 * nc + nw + tb + 1;
  const int nqv = (t >= 31) ? ((t - 31) >> 4) : -1;
  const u16* kcb = (const u16*)(p.ws + OFF_KC) + (size_t)bh * 512 * 64;
  const u16* vcb = (const u16*)(p.ws + OFF_VCT) + (size_t)bh * 64 * 512;
  const u16* ksb = proj + (size_t)b * S_ * PW + 1792 + hk * 64;
  const u16* vsb = (const u16*)(p.ws + OFF_VTS) + (size_t)bh * 64 * S_;
  const u16* kwb = proj + (size_t)b * S_ * PW + 2048 + hk * 64;
  const u16* vwb = (const u16*)(p.ws + OFF_VTW) + (size_t)bh * 64 * S_;
  const int srow = tid >> 3, sch = (tid & 7) * 8;
  const int klr = 16 * (2 * (srow >> 5) + ((srow >> 2) & 1)) + 4 * ((srow >> 3) & 3) + (srow & 3);
  const int koff = klr * KROW + sch, voff = srow * KROW + sch;
  uint4 rk0 = make_uint4(0,0,0,0), rk1 = rk0, rv0 = rk0, rv1 = rk0;
#define LDBLK(u_, rk_, rv_) do { const int uu_ = (u_); const u16 *kp_, *vp_; \
    if (uu_ < 2 * nc) { const int bl_ = (uu_ < nc) ? uu_ : uu_ - nc; kp_ = kcb + (size_t)(bl_ * 64 + srow) * 64 + sch; vp_ = vcb + (size_t)srow * 512 + bl_ * 64 + sch; } \
    else if (uu_ < 2 * nc + nw) { const int bl_ = wb0 + (uu_ - 2 * nc); kp_ = kwb + (size_t)(bl_ * 64 + srow) * PW + sch; vp_ = vwb + (size_t)srow * S_ + bl_ * 64 + sch; } \
    else { const int bl_ = uu_ - 2 * nc - nw; kp_ = ksb + (size_t)(bl_ * 64 + srow) * PW + sch; vp_ = vsb + (size_t)srow * S_ + bl_ * 64 + sch; } \
    rk_ = *(const uint4*)kp_; rv_ = *(const uint4*)vp_; } while (0)
  const int nst = (U + 1) >> 1;
  LDBLK(0, rk0, rv0);
  if (1 < U) LDBLK(1, rk1, rv1);
  *(uint4*)(stg + koff) = rk0; *(uint4*)(stg + STG + voff) = rv0;
  *(uint4*)(stg + 2 * STG + koff) = rk1; *(uint4*)(stg + 3 * STG + voff) = rv1;
  __syncthreads();
  float m_run = NEGF, l_run = 0.f, inv = 0.f;
  unsigned long long mylo = 0, myhi = 0, ulo = 0, uhi = 0;
  for (int s = 0; s < nst; s++) {
    if (s + 1 < nst) {
      LDBLK(2 * s + 2, rk0, rv0);
      if (2 * s + 3 < U) LDBLK(2 * s + 3, rk1, rv1);
    }
    const u16* sb = stg + (s & 1) * 4 * STG;
#pragma unroll
    for (int half = 0; half < 2; half++) {
      const int u = 2 * s + half;
      if (u >= U) break;
      const u16* Ks = sb + half * 2 * STG;
      const u16* Vs = Ks + STG;
      if (u < nc) {
        f32x4 st[4];
        qk_lds(Ks, q0, q1, st, lane);
        float bm = NEGF;
#pragma unroll
        for (int i = 0; i < 4; i++)
#pragma unroll
          for (int r = 0; r < 4; r++) {
            const int n = u * 64 + 32 * (i >> 1) + 8 * h + 4 * (i & 1) + r;
            const float v = (n <= nqv) ? st[i][r] : NEGF;
            st[i][r] = v; bm = fmaxf(bm, v);
          }
        bm = fmaxf(bm, __shfl_xor(bm, 16)); bm = fmaxf(bm, __shfl_xor(bm, 32));
        const float mn = fmaxf(m_run, bm);
        float ps = 0.f;
#pragma unroll
        for (int i = 0; i < 4; i++)
#pragma unroll
          for (int r = 0; r < 4; r++) ps += (st[i][r] > -1e29f) ? __expf(st[i][r] - mn) : 0.f;
        l_run = l_run * __expf(m_run - mn) + ps; m_run = mn;
        if (u == nc - 1) {
          float lt = l_run; lt += __shfl_xor(lt, 16); lt += __shfl_xor(lt, 32);
          inv = lt > 0.f ? 1.f / lt : 0.f;
        }
      } else if (u < 2 * nc) {
        const int blk = u - nc;
        f32x4 st[4];
        qk_lds(Ks, q0, q1, st, lane);
#pragma unroll
        for (int i = 0; i < 4; i++) {
          float a4 = 0.f, b3 = 0.f;
#pragma unroll
          for (int r = 0; r < 4; r++) {
            const int n = blk * 64 + 32 * (i >> 1) + 8 * h + 4 * (i & 1) + r;
            const float pv = (n <= nqv) ? __expf(st[i][r] - m_run) * inv : 0.f;
            st[i][r] = pv; a4 += pv; if (r == 3) b3 = pv;
          }
          a4 += __shfl_xor(a4, 1); a4 += __shfl_xor(a4, 2);
          b3 += __shfl_xor(b3, 1); b3 += __shfl_xor(b3, 2);
          if (g == 0) {
            const int j = blk * 16 + 8 * (i >> 1) + 2 * h + (i & 1);
            *(float2*)(impw + (qi * 128 + j) * 2) = make_float2(a4, b3);
          }
        }
        pv_lds(Vs, packp(st[0], st[1]), packp(st[2], st[3]), o, lane);
        if (u == 2 * nc - 1) {
#pragma unroll
          for (int mt = 0; mt < 4; mt++) {
            outa[mt][0] += gt0 * o[mt][0]; outa[mt][1] += gt0 * o[mt][1]; outa[mt][2] += gt0 * o[mt][2]; outa[mt][3] += gt0 * o[mt][3];
            o[mt] = (f32x4){0.f, 0.f, 0.f, 0.f};
          }
          m_run = NEGF; l_run = 0.f;
          asm volatile("s_waitcnt lgkmcnt(0)" ::: "memory");
          if (tb <= 15) { mylo = (2ull << tb) - 1ull; ulo = mylo; }
          else {
            for (int qq = 0; qq < 4; qq++) {
              const float* iw = impw + qq * 256;
              const int j0 = lane, j1 = lane + 64;
              const bool c0ok = (j0 >= 1 && j0 <= tb - 2), c1ok = (j1 <= tb - 2);
              unsigned k0 = 0, k1 = 0;
              if (c0ok) k0 = __float_as_uint(iw[2 * j0] + iw[2 * j0 - 1]) + 1u;
              if (c1ok) k1 = __float_as_uint(iw[2 * j1] + iw[2 * j1 - 1]) + 1u;
              unsigned thr = 0;
              for (int bit = 30; bit >= 0; bit--) {
                const unsigned trial = thr | (1u << bit);
                const int cnt = __popcll(__ballot(k0 >= trial)) + __popcll(__ballot(k1 >= trial));
                if (cnt >= 13) thr = trial;
              }
              const unsigned long long glo = __ballot(k0 > thr), ghi = __ballot(k1 > thr);
              const unsigned long long elo = __ballot(k0 == thr), ehi = __ballot(k1 == thr);
              const int need = 13 - __popcll(glo) - __popcll(ghi);
              const unsigned long long ltm = (1ull << lane) - 1ull;
              const int pre0 = __popcll(elo & ltm), pre1 = __popcll(elo) + __popcll(ehi & ltm);
              const bool s0 = (k0 > thr) || (k0 == thr && pre0 < need) || j0 == 0 || j0 == tb || j0 == tb - 1;
              const bool s1 = (k1 > thr) || (k1 == thr && pre1 < need) || j1 == tb || j1 == tb - 1;
              const unsigned long long blo = __ballot(s0), bhi_ = __ballot(s1);
              if (qi == qq) { mylo = blo; myhi = bhi_; }
              ulo |= blo; uhi |= bhi_;
            }
          }
        }
      } else if (u < 2 * nc + nw) {
        const int kbase = (wb0 + (u - 2 * nc)) * 64;
        if (kbase + 63 <= t0 && kbase > t0 + 3 - 512) attn_lds<0>(Ks, Vs, q0, q1, m_run, l_run, o, [&](int kk) { return true; }, true, lane);
        else attn_lds<2>(Ks, Vs, q0, q1, m_run, l_run, o, [&](int kk) { const int kp = kbase + kk; return (kp <= t) && (kp > t - 512); }, true, lane);
        if (u == 2 * nc + nw - 1) {
          float lt = l_run; lt += __shfl_xor(lt, 16); lt += __shfl_xor(lt, 32);
          const float w = lt > 0.f ? gt2 / lt : 0.f;
#pragma unroll
          for (int mt = 0; mt < 4; mt++) {
            outa[mt][0] += w * o[mt][0]; outa[mt][1] += w * o[mt][1]; outa[mt][2] += w * o[mt][2]; outa[mt][3] += w * o[mt][3];
            o[mt] = (f32x4){0.f, 0.f, 0.f, 0.f};
          }
          m_run = NEGF; l_run = 0.f;
        }
      } else {
        const int blk = u - 2 * nc - nw;
        const unsigned long long um = rfl64(blk < 64 ? ulo : uhi);
        if ((um >> (blk & 63)) & 1ull) {
          const bool selq = ((blk < 64 ? mylo : myhi) >> (blk & 63)) & 1ull;
          const int kbase = blk * 64;
          if (blk < tb) attn_lds<1>(Ks, Vs, q0, q1, m_run, l_run, o, [&](int kk) { return true; }, selq, lane);
          else attn_lds<2>(Ks, Vs, q0, q1, m_run, l_run, o, [&](int kk) { return selq && (kbase + kk <= t); }, selq, lane);
        }
      }
    }
    if (s + 1 < nst) {
      u16* db = stg + ((s + 1) & 1) * 4 * STG;
      *(uint4*)(db + koff) = rk0; *(uint4*)(db + STG + voff) = rv0;
      *(uint4*)(db + 2 * STG + koff) = rk1; *(uint4*)(db + 3 * STG + voff) = rv1;
    }
    __syncthreads();
  }
#undef LDBLK
  {
    float lt = l_run; lt += __shfl_xor(lt, 16); lt += __shfl_xor(lt, 32);
    const float w = lt > 0.f ? gt1 / lt : 0.f;
#pragma unroll
    for (int mt = 0; mt < 4; mt++) { outa[mt][0] += w * o[mt][0]; outa[mt][1] += w * o[mt][1]; outa[mt][2] += w * o[mt][2]; outa[mt][3] += w * o[mt][3]; }
  }
  u16* mo = (u16*)(p.ws + OFF_MIX) + (size_t)(b * S_ + t) * 1024 + 256 + (hk * 4 + g) * 64 + 4 * h;
#pragma unroll
  for (int mt = 0; mt < 4; mt++) {
    uint2 pk; pk.x = pack2(outa[mt][0], outa[mt][1]); pk.y = pack2(outa[mt][2], outa[mt][3]);
    *(uint2*)(mo + 16 * mt) = pk;
  }
}


DI void load_frags(const u16* Ks, const u16* Vs, bf16x8 (&kf)[8], bf16x8 (&vf)[8], int lane) {
  const u16* kp = Ks + (lane & 15) * KROW + 8 * (lane >> 4);
  const u16* vp = Vs + (lane & 15) * KROW + 8 * (lane >> 4);
#pragma unroll
  for (int i = 0; i < 4; i++) { kf[2 * i] = *(const bf16x8*)(kp + i * 16 * KROW); kf[2 * i + 1] = *(const bf16x8*)(kp + i * 16 * KROW + 32); }
#pragma unroll
  for (int i = 0; i < 4; i++) { vf[2 * i] = *(const bf16x8*)(vp + i * 16 * KROW); vf[2 * i + 1] = *(const bf16x8*)(vp + i * 16 * KROW + 32); }
}
template <int MODE, class MF>
DI void attn_core(const bf16x8 (&kf)[8], const bf16x8 (&vf)[8], bf16x8 q0, bf16x8 q1, float& m_run, float& l_run, f32x4 (&o)[4], MF mask, bool selq, int lane) {
  f32x4 st[4];
#pragma unroll
  for (int i = 0; i < 4; i++) {
    f32x4 z = {0.f, 0.f, 0.f, 0.f};
    z = mfma16(kf[2 * i], q0, z);
    st[i] = mfma16(kf[2 * i + 1], q1, z);
  }
  const int h = lane >> 4;
  float bm = NEGF;
#pragma unroll
  for (int i = 0; i < 4; i++)
#pragma unroll
    for (int r = 0; r < 4; r++) {
      if (MODE == 2) {
        const int kk = 32 * (i >> 1) + 8 * h + 4 * (i & 1) + r;
        st[i][r] = mask(kk) ? st[i][r] : NEGF;
      }
      bm = fmaxf(bm, st[i][r]);
    }
  if (MODE == 1) bm = selq ? bm : NEGF;
  bm = xmax32(xmax16(bm));
  const float mn = fmaxf(m_run, bm);
  const float sc = __builtin_amdgcn_exp2f((m_run - mn) * LOG2E);
  float mns = fmaxf(mn, -1e20f) * LOG2E;
  if (MODE == 1) mns = selq ? mns : 1e30f;
  float ps = 0.f;
#pragma unroll
  for (int i = 0; i < 4; i++)
#pragma unroll
    for (int r = 0; r < 4; r++) {
      const float pv = __builtin_amdgcn_exp2f(fmaf(st[i][r], LOG2E, -mns));
      st[i][r] = pv; ps += pv;
    }
  l_run = l_run * sc + ps; m_run = mn;
#pragma unroll
  for (int mt = 0; mt < 4; mt++) { o[mt][0] *= sc; o[mt][1] *= sc; o[mt][2] *= sc; o[mt][3] *= sc; }
  const bf16x8 p0 = packp(st[0], st[1]), p1 = packp(st[2], st[3]);
#pragma unroll
  for (int mt = 0; mt < 4; mt++) {
    o[mt] = mfma16(vf[2 * mt], p0, o[mt]);
    o[mt] = mfma16(vf[2 * mt + 1], p1, o[mt]);
  }
}


DI void load_k(const u16* Ks, bf16x8 (&kf)[8], int lane) {
  const u16* kp = Ks + (lane & 15) * KROW + 8 * (lane >> 4);
#pragma unroll
  for (int i = 0; i < 4; i++) { kf[2 * i] = *(const bf16x8*)(kp + i * 16 * KROW); kf[2 * i + 1] = *(const bf16x8*)(kp + i * 16 * KROW + 32); }
}
template <class MF>
DI void qk_part(const bf16x8 (&kf)[8], bf16x8 q0, bf16x8 q1, f32x4 (&st)[4], bool domask, MF mask, int lane) {
#pragma unroll
  for (int i = 0; i < 4; i++) {
    f32x4 z = {0.f, 0.f, 0.f, 0.f};
    z = mfma16(kf[2 * i], q0, z);
    st[i] = mfma16(kf[2 * i + 1], q1, z);
  }
  if (domask) {
#pragma unroll
    for (int i = 0; i < 4; i++)
#pragma unroll
      for (int r = 0; r < 4; r++) {
        const int cc = 32 * (i >> 1) + 4 * (i & 1) + r;
        st[i][r] = mask(cc) ? st[i][r] : NEGF;
      }
  }
}
DI void sm_pv_part(f32x4 (&st)[4], const bf16x8 (&vf)[8], float& m_run, float& l_run, f32x4 (&o)[4], bool selq, int lane) {
  float bm = NEGF;
#pragma unroll
  for (int i = 0; i < 4; i++)
#pragma unroll
    for (int r = 0; r < 4; r++) bm = fmaxf(bm, st[i][r]);
  bm = selq ? bm : NEGF;
  bm = xmax32(xmax16(bm));
  if (!__all(bm - m_run <= 8.f)) {
    const float mn = fmaxf(m_run, bm);
    const float sc = __builtin_amdgcn_exp2f((m_run - mn) * LOG2E);
    l_run *= sc; m_run = mn;
#pragma unroll
    for (int mt = 0; mt < 4; mt++) { o[mt][0] *= sc; o[mt][1] *= sc; o[mt][2] *= sc; o[mt][3] *= sc; }
  }
  float mns = fmaxf(m_run, -1e20f) * LOG2E;
  mns = selq ? mns : 1e30f;
  float ps = 0.f;
#pragma unroll
  for (int i = 0; i < 4; i++)
#pragma unroll
    for (int r = 0; r < 4; r++) {
      const float pv = __builtin_amdgcn_exp2f(fmaf(st[i][r], LOG2E, -mns));
      st[i][r] = pv; ps += pv;
    }
  l_run += ps;
  const bf16x8 p0 = packp(st[0], st[1]), p1 = packp(st[2], st[3]);
#pragma unroll
  for (int mt = 0; mt < 4; mt++) {
    o[mt] = mfma16(vf[2 * mt], p0, o[mt]);
    o[mt] = mfma16(vf[2 * mt + 1], p1, o[mt]);
  }
}

constexpr int NSA3_SMEM = 8 * STG * 2 + 8 * 8192;

DI void nsa_item3(const P& p, int item, char* smem) {
  const int tid = tidx(), lane = tid & 63, wid = __builtin_amdgcn_readfirstlane(tid >> 6);
  const int bh = item & 7, qt = 127 - (item >> 3);
  const int b = bh >> 1, hk = bh & 1;
  const int t0w = qt * 64 + wid * 8;
  u16* stg = (u16*)smem;
  float* impw = (float*)(smem + 8 * STG * 2) + wid * 2048;
  const int col = lane & 15, h = lane >> 4, qi = col >> 2, g = col & 3;
  const u16* proj = (const u16*)(p.ws + OFF_BIG);
  const int tqb = t0w + qi;
  bf16x8 q0[2], q1[2];
  float m_run[2], l_run[2], inv[2];
  f32x4 o[2][4];
  unsigned long long mylo[2], myhi[2], ulo[2], uhi[2];
#pragma unroll
  for (int c = 0; c < 2; c++) {
    const size_t rowq = (size_t)(b * S_ + tqb + 4 * c) * PW;
    q0[c] = *(const bf16x8*)(proj + rowq + 1024 + (hk * 4 + g) * 64 + 8 * h);
    q1[c] = *(const bf16x8*)(proj + rowq + 1024 + (hk * 4 + g) * 64 + 32 + 8 * h);
    m_run[c] = NEGF; l_run[c] = 0.f; inv[c] = 0.f;
    mylo[c] = 0; myhi[c] = 0; ulo[c] = 0; uhi[c] = 0;
#pragma unroll
    for (int mt = 0; mt < 4; mt++) o[c][mt] = (f32x4){0.f, 0.f, 0.f, 0.f};
  }
  const int tb = qt;
  const int nc = (qt >> 4) + 1;
  const int wb0 = (qt >= 8) ? (qt - 8) : 0;
  const int nw = tb - wb0 + 1;
  const int U = 2 * nc + nw + tb + 1;
  const u16* kcb = (const u16*)(p.ws + OFF_KC) + (size_t)bh * 512 * 64;
  const u16* vcb = (const u16*)(p.ws + OFF_VCT) + (size_t)bh * 64 * 512;
  const u16* ksb = proj + (size_t)b * S_ * PW + 1792 + hk * 64;
  const u16* vsb = (const u16*)(p.ws + OFF_VTS) + (size_t)bh * 64 * S_;
  const u16* kwb = proj + (size_t)b * S_ * PW + 2048 + hk * 64;
  const u16* vwb = (const u16*)(p.ws + OFF_VTW) + (size_t)bh * 64 * S_;
  const int srow = tid >> 3, sch = (tid & 7) * 8;
  const int klr = 16 * (2 * (srow >> 5) + ((srow >> 2) & 1)) + 4 * ((srow >> 3) & 3) + (srow & 3);
  const int koff = klr * KROW + sch, voff = srow * KROW + sch;
  uint4 rk0 = make_uint4(0, 0, 0, 0), rk1 = rk0, rv0 = rk0, rv1 = rk0;
#define LDBLK(u_, rk_, rv_) do { const int uu_ = (u_); const u16 *kp_, *vp_; int sr_ = srow; asm volatile("" : "+v"(sr_)); \
    if (uu_ < 2 * nc) { const int bl_ = (uu_ < nc) ? uu_ : uu_ - nc; kp_ = kcb + (unsigned)((bl_ * 64 + sr_) * 64 + sch); vp_ = vcb + (unsigned)(sr_ * 512 + bl_ * 64 + sch); } \
    else if (uu_ < 2 * nc + nw) { const int bl_ = wb0 + (uu_ - 2 * nc); kp_ = kwb + (unsigned)((bl_ * 64 + sr_) * PW + sch); vp_ = vwb + (unsigned)(sr_ * S_ + bl_ * 64 + sch); } \
    else { const int bl_ = uu_ - 2 * nc - nw; kp_ = ksb + (unsigned)((bl_ * 64 + sr_) * PW + sch); vp_ = vsb + (unsigned)(sr_ * S_ + bl_ * 64 + sch); } \
    rk_ = *(const uint4*)kp_; rv_ = *(const uint4*)vp_; } while (0)
#define EMIT_GATE(c_, gidx_, lt_) \
    int tql_ = tqb + 4 * (c_); asm volatile("" : "+v"(tql_)); \
    const float gate_ = sigm(bf2f(proj[(size_t)(b * S_ + tql_) * PW + 2304 + hk * 12 + g * 3 + (gidx_)])); \
    const float w_ = (lt_) > 0.f ? gate_ / (lt_) : 0.f; \
    float4* ps_ = (float4*)impw + ((c_) * 4) * 64 + lane;
#define EMIT_LDS(c_, gidx_, lt_, first_) do { EMIT_GATE(c_, gidx_, lt_) \
    _Pragma("unroll") for (int mt = 0; mt < 4; mt++) { \
      float4 a_ = make_float4(w_ * o[c_][mt][0], w_ * o[c_][mt][1], w_ * o[c_][mt][2], w_ * o[c_][mt][3]); \
      if (!(first_)) { const float4 pr_ = ps_[mt * 64]; a_.x += pr_.x; a_.y += pr_.y; a_.z += pr_.z; a_.w += pr_.w; } \
      ps_[mt * 64] = a_; \
      o[c_][mt] = (f32x4){0.f, 0.f, 0.f, 0.f}; } \
    m_run[c_] = NEGF; l_run[c_] = 0.f; } while (0)
#define EMIT_FINAL(c_, gidx_, lt_) do { EMIT_GATE(c_, gidx_, lt_) \
    u16* mo_ = (u16*)(p.ws + OFF_MIX) + (size_t)(b * S_ + tql_) * 1024 + 256 + (hk * 4 + g) * 64 + 4 * h; \
    _Pragma("unroll") for (int mt = 0; mt < 4; mt++) { \
      const float4 pr_ = ps_[mt * 64]; \
      uint2 pk_; pk_.x = pack2(pr_.x + w_ * o[c_][mt][0], pr_.y + w_ * o[c_][mt][1]); pk_.y = pack2(pr_.z + w_ * o[c_][mt][2], pr_.w + w_ * o[c_][mt][3]); \
      *(uint2*)(mo_ + 16 * mt) = pk_; } } while (0)
  const int nst = (U + 1) >> 1;
  LDBLK(0, rk0, rv0);
  if (1 < U) LDBLK(1, rk1, rv1);
  *(uint4*)(stg + koff) = rk0; *(uint4*)(stg + STG + voff) = rv0;
  *(uint4*)(stg + 2 * STG + koff) = rk1; *(uint4*)(stg + 3 * STG + voff) = rv1;
  __syncthreads();
  for (int s = 0; s < nst; s++) {
    if (s + 1 < nst) {
      LDBLK(2 * s + 2, rk0, rv0);
      if (2 * s + 3 < U) LDBLK(2 * s + 3, rk1, rv1);
    }
    const u16* sb = stg + (s & 1) * 4 * STG;
#pragma unroll 1
    for (int half = 0; half < 2; half++) {
      const int u = 2 * s + half;
      if (u >= U) break;
      const u16* Ks = sb + half * 2 * STG;
      const u16* Vs = Ks + STG;
      if (u < nc) {
        bf16x8 kf[8];
        load_k(Ks, kf, lane);
#pragma unroll
        for (int c = 0; c < 2; c++) {
          f32x4 st[4];
          int nlim = ((tqb + 4 * c - 31) >> 4) - u * 64 - 8 * h; asm volatile("" : "+v"(nlim));
          qk_part(kf, q0[c], q1[c], st, true, [&](int cc) { return cc <= nlim; }, lane);
          float bm = NEGF;
#pragma unroll
          for (int i = 0; i < 4; i++)
#pragma unroll
            for (int r = 0; r < 4; r++) bm = fmaxf(bm, st[i][r]);
          bm = xmax32(xmax16(bm));
          const float mn = fmaxf(m_run[c], bm);
          const float mns = fmaxf(mn, -1e20f) * LOG2E;
          float ps = 0.f;
#pragma unroll
          for (int i = 0; i < 4; i++)
#pragma unroll
            for (int r = 0; r < 4; r++) ps += __builtin_amdgcn_exp2f(fmaf(st[i][r], LOG2E, -mns));
          l_run[c] = l_run[c] * __builtin_amdgcn_exp2f((m_run[c] - mn) * LOG2E) + ps; m_run[c] = mn;
          if (u == nc - 1) {
            float lt = l_run[c]; lt += __shfl_xor(lt, 16); lt += __shfl_xor(lt, 32);
            inv[c] = lt > 0.f ? 1.f / lt : 0.f;
          }
        }
      } else if (u < 2 * nc) {
        const int blk = u - nc;
        bf16x8 kf[8];
        load_k(Ks, kf, lane);
        f32x4 st0[4], st1[4];
        { int nlim = ((tqb - 31) >> 4) - blk * 64 - 8 * h; asm volatile("" : "+v"(nlim)); qk_part(kf, q0[0], q1[0], st0, true, [&](int cc) { return cc <= nlim; }, lane); }
        { int nlim = ((tqb + 4 - 31) >> 4) - blk * 64 - 8 * h; asm volatile("" : "+v"(nlim)); qk_part(kf, q0[1], q1[1], st1, true, [&](int cc) { return cc <= nlim; }, lane); }
        bf16x8 vf[8];
        load_k(Vs, vf, lane);
#pragma unroll
        for (int c = 0; c < 2; c++) {
          f32x4 (&st)[4] = c == 0 ? st0 : st1;
          const float mns = fmaxf(m_run[c], -1e20f) * LOG2E;
          const float iv = inv[c];
#pragma unroll
          for (int i = 0; i < 4; i++) {
            float a4 = 0.f, b3 = 0.f;
#pragma unroll
            for (int r = 0; r < 4; r++) {
              const float pv = __builtin_amdgcn_exp2f(fmaf(st[i][r], LOG2E, -mns)) * iv;
              st[i][r] = pv; a4 += pv; if (r == 3) b3 = pv;
            }
            a4 += __shfl_xor(a4, 1); a4 += __shfl_xor(a4, 2);
            b3 += __shfl_xor(b3, 1); b3 += __shfl_xor(b3, 2);
            if (g == 0) {
              const int j = blk * 16 + 8 * (i >> 1) + 2 * h + (i & 1);
              *(float2*)(impw + ((c * 4 + qi) * 128 + j) * 2) = make_float2(a4, b3);
            }
          }
          const bf16x8 p0 = packp(st[0], st[1]), p1 = packp(st[2], st[3]);
#pragma unroll
          for (int mt = 0; mt < 4; mt++) {
            o[c][mt] = mfma16(vf[2 * mt], p0, o[c][mt]);
            o[c][mt] = mfma16(vf[2 * mt + 1], p1, o[c][mt]);
          }
        }
        if (u == 2 * nc - 1) {
          asm volatile("s_waitcnt lgkmcnt(0)" ::: "memory");
          if (tb <= 15) { mylo[0] = mylo[1] = (2ull << tb) - 1ull; ulo[0] = ulo[1] = mylo[0]; }
          else {
            for (int qq = 0; qq < 8; qq++) {
              const float* iw = impw + qq * 256;
              const int j0 = lane, j1 = lane + 64;
              const bool c0ok = (j0 >= 1 && j0 <= tb - 2), c1ok = (j1 <= tb - 2);
              unsigned k0 = 0, k1 = 0;
              if (c0ok) k0 = __float_as_uint(iw[2 * j0] + iw[2 * j0 - 1]) + 1u;
              if (c1ok) k1 = __float_as_uint(iw[2 * j1] + iw[2 * j1 - 1]) + 1u;
              unsigned thr = 0;
              for (int bit = 30; bit >= 0; bit--) {
                const unsigned trial = thr | (1u << bit);
                const int cnt = __popcll(__ballot(k0 >= trial)) + __popcll(__ballot(k1 >= trial));
                if (cnt >= 13) thr = trial;
              }
              const unsigned long long glo = __ballot(k0 > thr), ghi = __ballot(k1 > thr);
              const unsigned long long elo = __ballot(k0 == thr), ehi = __ballot(k1 == thr);
              const int need = 13 - __popcll(glo) - __popcll(ghi);
              int ln_ = lane; asm volatile("" : "+v"(ln_));
              const unsigned long long ltm = (1ull << ln_) - 1ull;
              const int pre0 = __popcll(elo & ltm), pre1 = __popcll(elo) + __popcll(ehi & ltm);
              const bool s0 = (k0 > thr) || (k0 == thr && pre0 < need) || j0 == 0 || j0 == tb || j0 == tb - 1;
              const bool s1 = (k1 > thr) || (k1 == thr && pre1 < need) || j1 == tb || j1 == tb - 1;
              const unsigned long long blo = __ballot(s0), bhi_ = __ballot(s1);
#pragma unroll
              for (int c = 0; c < 2; c++) {
                if ((qq >> 2) == c) {
                  if (qi == (qq & 3)) { mylo[c] = blo; myhi[c] = bhi_; }
                  ulo[c] |= blo; uhi[c] |= bhi_;
                }
              }
            }
          }
                  asm volatile("s_waitcnt lgkmcnt(0)" ::: "memory");
#pragma unroll
          for (int c = 0; c < 2; c++) EMIT_LDS(c, 0, 1.f, true);
        }
      } else if (u < 2 * nc + nw) {
        const int kbase = (wb0 + (u - 2 * nc)) * 64;
        bf16x8 kf[8];
        load_k(Ks, kf, lane);
        f32x4 st0[4], st1[4];
        {
          const int t0c = t0w; int lim = tqb - kbase - 8 * h; asm volatile("" : "+v"(lim));
          qk_part(kf, q0[0], q1[0], st0, !(kbase + 63 <= t0c && kbase > t0c + 3 - 512), [&](int cc) { return (cc <= lim) && (cc > lim - 512); }, lane);
        }
        {
          const int t0c = t0w + 4; int lim = tqb + 4 - kbase - 8 * h; asm volatile("" : "+v"(lim));
          qk_part(kf, q0[1], q1[1], st1, !(kbase + 63 <= t0c && kbase > t0c + 3 - 512), [&](int cc) { return (cc <= lim) && (cc > lim - 512); }, lane);
        }
        bf16x8 vf[8];
        load_k(Vs, vf, lane);
        sm_pv_part(st0, vf, m_run[0], l_run[0], o[0], true, lane);
        sm_pv_part(st1, vf, m_run[1], l_run[1], o[1], true, lane);
        if (u == 2 * nc + nw - 1) {
#pragma unroll
          for (int c = 0; c < 2; c++) {
            float lt = l_run[c]; lt += __shfl_xor(lt, 16); lt += __shfl_xor(lt, 32);
            EMIT_LDS(c, 2, lt, false);
          }
        }
      } else {
        const int blk = u - 2 * nc - nw;
        const unsigned long long um0 = rfl64(blk < 64 ? ulo[0] : uhi[0]), um1 = rfl64(blk < 64 ? ulo[1] : uhi[1]);
        const bool need0 = (um0 >> (blk & 63)) & 1ull, need1 = (um1 >> (blk & 63)) & 1ull;
        const int kbase = blk * 64;
        const bool domask = blk >= tb;
        if (need0 && need1) {
          const bool sel0 = ((blk < 64 ? mylo[0] : myhi[0]) >> (blk & 63)) & 1ull;
          const bool sel1 = ((blk < 64 ? mylo[1] : myhi[1]) >> (blk & 63)) & 1ull;
          bf16x8 kf[8];
          load_k(Ks, kf, lane);
          f32x4 st0[4], st1[4];
          { int lim = tqb - kbase - 8 * h; asm volatile("" : "+v"(lim)); qk_part(kf, q0[0], q1[0], st0, domask, [&](int cc) { return cc <= lim; }, lane); }
          { int lim = tqb + 4 - kbase - 8 * h; asm volatile("" : "+v"(lim)); qk_part(kf, q0[1], q1[1], st1, domask, [&](int cc) { return cc <= lim; }, lane); }
          bf16x8 vf[8];
          load_k(Vs, vf, lane);
          sm_pv_part(st0, vf, m_run[0], l_run[0], o[0], sel0, lane);
          sm_pv_part(st1, vf, m_run[1], l_run[1], o[1], sel1, lane);
        } else if (need0) {
          const bool sel0 = ((blk < 64 ? mylo[0] : myhi[0]) >> (blk & 63)) & 1ull;
          bf16x8 kf[8];
          load_k(Ks, kf, lane);
          f32x4 st0[4];
          { int lim = tqb - kbase - 8 * h; asm volatile("" : "+v"(lim)); qk_part(kf, q0[0], q1[0], st0, domask, [&](int cc) { return cc <= lim; }, lane); }
          bf16x8 vf[8];
          load_k(Vs, vf, lane);
          sm_pv_part(st0, vf, m_run[0], l_run[0], o[0], sel0, lane);
        } else if (need1) {
          const bool sel1 = ((blk < 64 ? mylo[1] : myhi[1]) >> (blk & 63)) & 1ull;
          bf16x8 kf[8];
          load_k(Ks, kf, lane);
          f32x4 st1[4];
          { int lim = tqb + 4 - kbase - 8 * h; asm volatile("" : "+v"(lim)); qk_part(kf, q0[1], q1[1], st1, domask, [&](int cc) { return cc <= lim; }, lane); }
          bf16x8 vf[8];
          load_k(Vs, vf, lane);
          sm_pv_part(st1, vf, m_run[1], l_run[1], o[1], sel1, lane);
        }
      }
    }
    if (s + 1 < nst) {
      u16* db = stg + ((s + 1) & 1) * 4 * STG;
      *(uint4*)(db + koff) = rk0; *(uint4*)(db + STG + voff) = rv0;
      *(uint4*)(db + 2 * STG + koff) = rk1; *(uint4*)(db + 3 * STG + voff) = rv1;
    }
    __syncthreads();
  }
#undef LDBLK
#pragma unroll
  for (int c = 0; c < 2; c++) {
    float lt = l_run[c]; lt += __shfl_xor(lt, 16); lt += __shfl_xor(lt, 32);
    EMIT_FINAL(c, 1, lt);
  }
#undef EMIT_GATE
#undef EMIT_LDS
#undef EMIT_FINAL
}

constexpr int N_PHASES = 2 + 9 * 4;

DI void run_phase(const P& p, int ph, char* smem, int* sh_next) {
  const int nb = gridDim.x, bid = blockIdx.x;
  u16* Hb = (u16*)(p.ws + OFF_H);
  u16* proj = (u16*)(p.ws + OFF_BIG);
  u16* mix = (u16*)(p.ws + OFF_MIX);
  if (ph == 0) {
    for (int it = bid; it < PREP_ITEMS; it += 4 * nb) {
      if (it + 3 * nb < PREP_TR) { const TJob js[4] = {decode_tr(p, it), decode_tr(p, it + nb), decode_tr(p, it + 2 * nb), decode_tr(p, it + 3 * nb)}; transpose_multi<4>(js, smem); }
      else { for (int q = 0; q < 4; q++) if (it + q * nb < PREP_ITEMS) prep_item(p, it + q * nb, smem); }
    }
    return;
  }
  if (ph == 1) { for (int it = bid; it < T_ / 8; it += nb) ln_rows(p, 0, 0, it); return; }
  const int l = (ph - 2) / 9, k = (ph - 2) % 9;
  switch (k) {
    case 0: {
      Epi256InProj ef{proj, (u16*)(p.ws + OFF_VTS), (u16*)(p.ws + OFF_VTW), (const float*)(p.ws + OFF_COS), (const float*)(p.ws + OFF_SIN)};
      const u16* W = (const u16*)(p.ws + OFF_WIN) + (size_t)l * NPI * 1024;
      for (int it = bid; it < 12 * 128; it += nb) { int pm, pn; g_tile_map(it, 12, 128, pm, pn); gemm256_tile<true>(W, Hb, 1024, pm * 256, pn * 256, ef, smem); }
    } break;
    case 1: {
      unsigned* qc = (unsigned*)(p.ws + OFF_BAR + 14336) + l * 2;
      int it = bid;
      for (;;) {
        if (it >= 64 + 1024 + 2048) break;
        unsigned nx = 0;
        if (threadIdx.x == 0) nx = nb + __hip_atomic_fetch_add(qc, 1u, __ATOMIC_RELAXED, __HIP_MEMORY_SCOPE_AGENT);
        if (it < 64) {
          const int kv = it >> 5, r = it & 31;
          ACmp af{proj, kv ? 1664 : 1536};
          EpiPlain ef{(u16*)(p.ws + OFF_CH) + (size_t)kv * 4096 * 256, 256, 2, (const float*)(p.ws + OFF_CB) + (l * 2 + kv) * 256};
          gemm_tile(af, (const u16*)(p.ws + OFF_CW1) + (size_t)(l * 2 + kv) * 256 * 2048, 2048, (r >> 1) * 256, (r & 1) * 128, ef, smem);
        } else if (it < 64 + 1024) gmlp_item(p, l, it - 64, smem);
        else hgrn_item(p, l, it - 64 - 1024, 0, smem);
        if (threadIdx.x == 0) *sh_next = (int)nx;
        __syncthreads();
        it = *sh_next;
        __syncthreads();
      }
    } break;
    case 2: {
      for (int it = bid; it < 32 + 256; it += nb) {
        if (it < 32) {
          const int kv = it >> 4, r = it & 15;
          APlain af{(const u16*)(p.ws + OFF_CH) + (size_t)kv * 4096 * 256, 256};
          EpiCmp2 ef{(u16*)(p.ws + OFF_KC), (u16*)(p.ws + OFF_VCT), kv};
          gemm_tile(af, (const u16*)(p.ws + OFF_CW2) + (size_t)(l * 2 + kv) * 128 * 256, 256, r * 256, 0, ef, smem);
        } else scan_item(p, it - 32);
      }
    } break;
    case 3: {
      unsigned* qc = (unsigned*)(p.ws + OFF_BAR + 14336) + l * 2 + 1;
      int it = bid;
      for (;;) {
        if (it >= 1024 + 2048) break;
        unsigned nx = 0;
        if (threadIdx.x == 0) nx = nb + __hip_atomic_fetch_add(qc, 1u, __ATOMIC_RELAXED, __HIP_MEMORY_SCOPE_AGENT);
        if (it < 1024) nsa_item3(p, it, smem);
        else hgrn_item(p, l, it - 1024, 1, smem);
        if (threadIdx.x == 0) *sh_next = (int)nx;
        __syncthreads();
        it = *sh_next;
        __syncthreads();
      }
    } break;
    case 4: {
      Epi256Plain ef{(u16*)p.out, 1024, 0};
      const u16* W = (const u16*)(p.ws + OFF_WO) + (size_t)l * 1024 * 1024;
      for (int it = bid; it < 4 * 128; it += nb) { int pm, pn; g_tile_map(it, 4, 128, pm, pn); gemm256_tile<false>(W, mix, 1024, pm * 256, pn * 256, ef, smem); }
    } break;
    case 5: { for (int it = bid; it < T_ / 32; it += nb) ln_rows(p, l, 1, it); } break;
    case 6: {
      Epi256Plain ef{proj, 4096, 1};
      const u16* W = (const u16*)(p.ws + OFF_FF1) + (size_t)l * 4096 * 1024;
      for (int it = bid; it < 16 * 128; it += nb) { int pm, pn; g_tile_map(it, 16, 128, pm, pn); gemm256_tile<true>(W, Hb, 1024, pm * 256, pn * 256, ef, smem); }
    } break;
    case 7: {
      Epi256Plain ef{l == 3 ? (u16*)(p.ws + OFF_YL) : (u16*)p.out, 1024, 0};
      const u16* W = (const u16*)(p.ws + OFF_FF2) + (size_t)l * 1024 * 4096;
      for (int it = bid; it < 4 * 128; it += nb) { int pm, pn; g_tile_map(it, 4, 128, pm, pn); gemm256_tile<false>(W, proj, 4096, pm * 256, pn * 256, ef, smem); }
    } break;
    case 8: { for (int it = bid; it < T_ / 32; it += nb) ln_rows(p, l, 2, it); } break;
  }
}

#define XB_TMO      128
#define XB_XCNT(j)  (256  + 64 * (j))
#define XB_XSUB(j)  (1280 + 64 * (j))
#define XB_XGEN(j)  (2304 + 64 * (j))
#define XB_TOP      3328
#define XB_TOPGEN   3392
#define XCD_BAR_WORDS 3456
#define XB_SPIN_CAP (1u << 18)
#define LAS __attribute__((address_space(3)))
DI unsigned xb_ld(unsigned* p) { return __hip_atomic_load(p, __ATOMIC_RELAXED, __HIP_MEMORY_SCOPE_AGENT); }
DI unsigned xb_add(unsigned* p, unsigned v) { return __hip_atomic_fetch_add(p, v, __ATOMIC_RELAXED, __HIP_MEMORY_SCOPE_AGENT); }
DI unsigned xb_xcc_id() { return (unsigned)__builtin_amdgcn_s_getreg((3 << 11) | 20) & 0xFu; }
#define XB_SPIN(cond, bar) do { unsigned _sp = 0; while (cond) { __builtin_amdgcn_s_sleep(1); \
    if ((++_sp & 255u) == 0u) { if (xb_ld(&(bar)[XB_TMO])) break; if (_sp > XB_SPIN_CAP) { atomicAdd(&(bar)[XB_TMO], 1u); break; } } } } while (0)
struct XcdBarrier { unsigned* bar; unsigned x; volatile LAS unsigned* st; };
DI XcdBarrier xcd_barrier_post(unsigned* bar, volatile LAS unsigned* st) {
  XcdBarrier b; b.bar = bar; b.x = xb_xcc_id(); b.st = st;
  if (threadIdx.x == 0) (void)xb_add(&bar[XB_XCNT(b.x)], 1u);
  return b;
}
DI void xcd_barrier_complete(unsigned* bar, unsigned x, unsigned& nloc, unsigned& nx) {
  const unsigned G = gridDim.x * gridDim.y * gridDim.z;
  unsigned sum, cnt, mine, sp = 0u;
  for (;;) {
    sum = 0u; cnt = 0u; mine = 0u;
#pragma unroll
    for (unsigned j = 0; j < 16; ++j) { const unsigned c = xb_ld(&bar[XB_XCNT(j)]); sum += c; cnt += (c > 0u) ? 1u : 0u; mine = (j == x) ? c : mine; }
    if (sum == G) break;
    __builtin_amdgcn_s_sleep(1);
    if ((++sp & 255u) == 0u) { if (xb_ld(&bar[XB_TMO])) break; if (sp > XB_SPIN_CAP) { atomicAdd(&bar[XB_TMO], 1u); break; } }
  }
  nloc = mine > 0u ? mine : 1u; nx = cnt > 0u ? cnt : 1u;
}
DI void xcd_barrier(const XcdBarrier& b) {
  asm volatile("s_waitcnt vmcnt(0)" ::: "memory");
  __syncthreads();
  if (threadIdx.x == 0) {
    unsigned* bar = b.bar;
    __builtin_amdgcn_s_waitcnt(0);
    unsigned nloc = b.st[0], nx = b.st[1];
    if (nloc == 0u) { xcd_barrier_complete(bar, b.x, nloc, nx); b.st[0] = nloc; b.st[1] = nx; }
    const unsigned old = xb_add(&bar[XB_XSUB(b.x)], 1u);
    const unsigned gen = old / nloc;
    if (old + 1u == (gen + 1u) * nloc) {
      __builtin_amdgcn_fence(__ATOMIC_RELEASE, "agent");
      asm volatile("s_waitcnt vmcnt(0)" ::: "memory");
      const unsigned og = xb_add(&bar[XB_TOP], 1u);
      const unsigned tg = og / nx;
      if (og + 1u == (tg + 1u) * nx) xb_add(&bar[XB_TOPGEN], 1u);
      else XB_SPIN(xb_ld(&bar[XB_TOPGEN]) == tg, bar);
      __builtin_amdgcn_fence(__ATOMIC_ACQUIRE, "agent");
      xb_add(&bar[XB_XGEN(b.x)], 1u);
      asm volatile("s_waitcnt vmcnt(0)" ::: "memory");
    } else {
      XB_SPIN(xb_ld(&bar[XB_XGEN(b.x)]) == gen, bar);
      __builtin_amdgcn_fence(__ATOMIC_ACQUIRE, "agent");
      asm volatile("s_waitcnt vmcnt(0)" ::: "memory");
    }
  }
  __syncthreads();
}

__global__ void __launch_bounds__(NT) mega(P p) {
  extern __shared__ __attribute__((aligned(16))) char smem[];
#if MULTI_LAUNCH
  __shared__ int sh_next[4];
  for (int ph = p.ph_lo; ph < p.ph_hi; ph++) run_phase(p, ph, smem, sh_next);
#else
  __shared__ uint4 xb_words;
  __shared__ int sh_next[4];
  cg::grid_group grid = cg::this_grid();
  unsigned* bar = (unsigned*)(p.ws + OFF_BAR);
  if (threadIdx.x == 0) xb_words = make_uint4(0u, 0u, 0u, 0u);
  if (blockIdx.x == 0) { for (int i = threadIdx.x; i < 4096; i += NT) __hip_atomic_store(&bar[i], 0u, __ATOMIC_RELAXED, __HIP_MEMORY_SCOPE_AGENT); }
  __syncthreads();
  XcdBarrier xb;
  for (int ph = p.ph_lo; ph < p.ph_hi; ph++) {
    const int reps = (ph >= 2 && ((p.rep_mask >> ((ph - 2) % 9)) & 1)) ? 2 : 1;
    for (int rp = 0; rp < reps; rp++) { run_phase(p, ph, smem, sh_next); if (rp + 1 < reps) xcd_barrier(xb); }
    if (ph + 1 < p.ph_hi) {
      if (ph == p.ph_lo) { grid.sync(); xb = xcd_barrier_post(bar, (volatile LAS unsigned*)&xb_words); }
      else xcd_barrier(xb);
    }
  }
#endif
}

extern "C" void kernel_launch(void* const* d_in, const int* in_sizes, int n_in, void* d_out, int out_size, void* d_ws, size_t ws_size, hipStream_t stream) {
  static int grid_blocks = 0;
  if (!grid_blocks) {
    int dev = 0, cus = 0, per_cu = 0;
    hipGetDevice(&dev);
    hipDeviceGetAttribute(&cus, hipDeviceAttributeMultiprocessorCount, dev);
    hipFuncSetAttribute((const void*)mega, hipFuncAttributeMaxDynamicSharedMemorySize, SMEM_BYTES);
    hipOccupancyMaxActiveBlocksPerMultiprocessor(&per_cu, (const void*)mega, NT, SMEM_BYTES);
    if (per_cu < 1) per_cu = 1;
    grid_blocks = cus * per_cu;
    if (ws_size < WS_END) fprintf(stderr, "workspace too small: %zu < %zu\n", ws_size, (size_t)WS_END);
  }
  P p{};
  for (int i = 0; i < 25; i++) p.in[i] = (const float*)d_in[i];
  p.out = (float*)d_out;
  p.ws = (char*)d_ws;
  for (int i = 0; i < 32; i++) p.invf[i] = pow(10000.0, -(double)i / 32.0);
  {
    const double c[16] = {-1.0 / 6, 1.0 / 120, -1.0 / 5040, 1.0 / 362880, -1.0 / 39916800, 1.0 / 6227020800.0,
                          -0.5, 1.0 / 24, -1.0 / 720, 1.0 / 40320, -1.0 / 3628800, 1.0 / 479001600.0, -1.0 / 87178291200.0,
                          0.6366197723675814, 1.5707963267948966, 6.123233995736766e-17};
    for (int i = 0; i < 16; i++) p.cf[i] = c[i];
  }
#if MULTI_LAUNCH
  for (int ph = 0; ph < N_PHASES; ph++) {
    p.ph_lo = ph; p.ph_hi = ph + 1;
    hipLaunchKernelGGL(mega, dim3(grid_blocks), dim3(NT), SMEM_BYTES, stream, p);
  }
#else
  p.ph_lo = 0; p.ph_hi = N_PHASES; p.rep_mask = REPMASK;
  void* args[] = {&p};
  hipError_t e = hipLaunchCooperativeKernel((const void*)mega, dim3(grid_blocks), dim3(NT), args, SMEM_BYTES, stream);
  if (e != hipSuccess) fprintf(stderr, "cooperative launch failed: %s (grid %d)\n", hipGetErrorString(e), grid_blocks);
#endif
}
```
